# Optimizing an MI355X kernel written in HIP

```python
import math
import jax
import jax.numpy as jnp
from jax import lax
import numpy as np


D_MODEL = 2048
BATCH = 16
SEQ = 2048
DEPTH = 2

GRID_W = 64
CTX_LEN = 256
N_MIXERS = 4
GROUP_WIDTH = D_MODEL // N_MIXERS
MIX_WIDTH = N_MIXERS * GROUP_WIDTH
N_IN_PARTS = 12
P_S5_U = 0
P_LRU_X = 1
P_LRU_GATE = 2
P_HG_Q = 3
P_HG_FF = 4
P_HG_FB = 5
P_HG_I = 6
P_HG_G = 7
P_RET_Q = 8
P_RET_K = 9
P_RET_V = 10
P_RET_G = 11
S5_CH = 16
S5_GROUPS = GROUP_WIDTH // S5_CH
S5_STATE = 64
S5_DT_MIN = 1e-3
S5_DT_MAX = 1e-1
LRU_HEADS = 8
LRU_HEAD_DIM = GROUP_WIDTH // LRU_HEADS
LRU_CONV = 4
LRU_C = 8.0
HGRN_HEADS = 4
HGRN_DIM = GROUP_WIDTH // HGRN_HEADS
RET_HEADS = 4
RET_DIM = GROUP_WIDTH // RET_HEADS
RET_DECAY_EXP_FWD = 5.0
RET_DECAY_EXP_BWD = 5.5
ROPE_BASE = 10000.0
CHUNK = 64
N_EXPERTS = 16
N_EXPERT_GROUPS = 4
EXPERTS_PER_GROUP = N_EXPERTS // N_EXPERT_GROUPS
TOP_K = 2
D_FF_EXPERT = D_MODEL // 2
EPS = 1e-6

kernel_name = 'hybrid_headgroup_flow_block'


def rms_norm(x, g):
    xf = x.astype(jnp.float32)
    y = xf * lax.rsqrt(jnp.mean(xf * xf, axis=-1, keepdims=True) + EPS)
    return (y * g.astype(jnp.float32)).astype(x.dtype)


def head_rms(x):
    return x * lax.rsqrt(jnp.mean(x * x, axis=-1, keepdims=True) + EPS)


def modulate(h, shift, scale):
    return h * (1.0 + scale) + shift


def flip_t(t):
    return jnp.flip(t, axis=1)


def gated_head_norm(o, g):
    return head_rms(o).reshape(g.shape) * jax.nn.silu(g.astype(jnp.float32))


def linear_scan(a, b, h0, reverse):
    def combine(e1, e2):
        return e1[0] * e2[0], e2[0] * e1[1] + e2[1]
    a_cum, h = lax.associative_scan(combine, (a, b), reverse=reverse, axis=1)
    return h + a_cum * h0[:, None]


def s5_states(u, h0_re, h0_im, lam_re, lam_im, log_dt, b_re, b_im, reverse):
    bsz, n, _ = u.shape
    ug = u.reshape(bsz, n, S5_GROUPS, S5_CH)
    dt = jnp.exp(log_dt.astype(jnp.float32))[:, None]
    lr, li = lam_re.astype(jnp.float32), lam_im.astype(jnp.float32)
    mag = jnp.exp(lr * dt)
    abar_re, abar_im = mag * jnp.cos(li * dt), mag * jnp.sin(li * dt)
    den = lr * lr + li * li
    zr = abar_re - 1.0
    w_re = (zr * lr + abar_im * li) / den
    w_im = (abar_im * lr - zr * li) / den
    bu_re = jnp.einsum('blgc,gcp->blgp', ug, b_re.astype(jnp.float32))
    bu_im = jnp.einsum('blgc,gcp->blgp', ug, b_im.astype(jnp.float32))
    drive_re = w_re * bu_re - w_im * bu_im
    drive_im = w_re * bu_im + w_im * bu_re
    a_re = jnp.broadcast_to(abar_re, (1, n) + abar_re.shape)
    a_im = jnp.broadcast_to(abar_im, (1, n) + abar_im.shape)

    def combine(e1, e2):
        a1r, a1i, b1r, b1i = e1
        a2r, a2i, b2r, b2i = e2
        return (a1r * a2r - a1i * a2i, a1r * a2i + a1i * a2r,
                a2r * b1r - a2i * b1i + b2r, a2r * b1i + a2i * b1r + b2i)

    p_re, p_im, h_re, h_im = lax.associative_scan(
        combine, (a_re, a_im, drive_re, drive_im), reverse=reverse, axis=1)
    h0r, h0i = h0_re[:, None], h0_im[:, None]
    return h_re + p_re * h0r - p_im * h0i, h_im + p_re * h0i + p_im * h0r


def s5_readout(h_re, h_im, c_re, c_im):
    bsz, n = h_re.shape[:2]
    y = (jnp.einsum('blgp,gpc->blgc', h_re, c_re.astype(jnp.float32))
         - jnp.einsum('blgp,gpc->blgc', h_im, c_im.astype(jnp.float32)))
    return y.reshape(bsz, n, GROUP_WIDTH)


def s5_glu(y, glu_w, glu_b):
    y = jax.nn.gelu(y)
    return y * jax.nn.sigmoid(y @ glu_w.astype(jnp.float32) + glu_b.astype(jnp.float32))


def s5_mixer(pc, pl, lam_re, lam_im, log_dt, b_re, b_im, c_re, c_im, d, glu_w, glu_b, ctx_out):
    u_c = pc[P_S5_U].astype(jnp.float32)
    u_l = pl[P_S5_U].astype(jnp.float32)
    d = d.astype(jnp.float32)
    zero = jnp.zeros((u_c.shape[0], S5_GROUPS, S5_STATE), jnp.float32)
    y_l = d * u_l
    y_c = d * u_c if ctx_out else None
    for dr in (0, 1):
        rev = dr == 1
        end = 0 if rev else -1
        prm = (lam_re[dr], lam_im[dr], log_dt[dr], b_re[dr], b_im[dr])
        hc_re, hc_im = s5_states(u_c, zero, zero, *prm, rev)
        hl_re, hl_im = s5_states(u_l, hc_re[:, end], hc_im[:, end], *prm, rev)
        y_l = y_l + s5_readout(hl_re, hl_im, c_re[dr], c_im[dr])
        if ctx_out:
            y_c = y_c + s5_readout(hc_re, hc_im, c_re[dr], c_im[dr])
    out_c = s5_glu(y_c, glu_w, glu_b) if ctx_out else None
    return out_c, s5_glu(y_l, glu_w, glu_b)


def short_conv(x, w, b):
    k = w.shape[0]
    left = k // 2
    y = lax.conv_general_dilated(x, w[:, None, :].astype(x.dtype), window_strides=(1,),
                                 padding=[(left, k - 1 - left)],
                                 dimension_numbers=('NWC', 'WIO', 'NWC'),
                                 feature_group_count=x.shape[-1])
    return y + b.astype(x.dtype)


def rglru_coefficients(x, wa, ba, wx, bx, lam):
    bsz, n, w = x.shape
    xh = x.reshape(bsz, n, LRU_HEADS, LRU_HEAD_DIM)
    r = jax.nn.sigmoid(jnp.einsum('blhi,hij->blhj', xh, wa.astype(jnp.float32)).reshape(bsz, n, w)
                       + ba.astype(jnp.float32))
    i = jax.nn.sigmoid(jnp.einsum('blhi,hij->blhj', xh, wx.astype(jnp.float32)).reshape(bsz, n, w)
                       + bx.astype(jnp.float32))
    log_a = -LRU_C * r * jax.nn.softplus(-lam.astype(jnp.float32))
    return jnp.exp(log_a), jnp.sqrt(-jnp.expm1(2.0 * log_a)) * (i * x)


def rglru_mixer(pc, pl, conv_w, conv_b, wa, ba, wx, bx, lam, ctx_out):
    x_c = short_conv(pc[P_LRU_X], conv_w, conv_b).astype(jnp.float32)
    x_l = short_conv(pl[P_LRU_X], conv_w, conv_b).astype(jnp.float32)
    zero = jnp.zeros((x_c.shape[0], GROUP_WIDTH), jnp.float32)
    h_c_sum, h_l_sum = 0.0, 0.0
    for dr in (0, 1):
        rev = dr == 1
        prm = (wa[dr], ba[dr], wx[dr], bx[dr], lam[dr])
        h_c = linear_scan(*rglru_coefficients(x_c, *prm), zero, rev)
        h_l = linear_scan(*rglru_coefficients(x_l, *prm), h_c[:, 0 if rev else -1], rev)
        h_l_sum = h_l_sum + h_l
        if ctx_out:
            h_c_sum = h_c_sum + h_c
    out_l = h_l_sum * jax.nn.gelu(pl[P_LRU_GATE].astype(jnp.float32))
    out_c = h_c_sum * jax.nn.gelu(pc[P_LRU_GATE].astype(jnp.float32)) if ctx_out else None
    return out_c, out_l


def chunk_gla(q, k, v, log_f, s0, with_out):
    bsz, n, h, _ = q.shape
    dv = v.shape[-1]
    nc = n // CHUNK

    def blocks(t):
        return t.reshape(bsz, nc, CHUNK, h, t.shape[-1]).transpose(1, 0, 3, 2, 4)

    lower = jnp.tril(jnp.ones((CHUNK, CHUNK), bool))[:, :, None]

    def step(s, blk):
        qb, kb, vb, gb = blk
        cum = jnp.cumsum(gb, axis=2)
        last = cum[:, :, -1:]
        s_new = (jnp.exp(last[:, :, 0])[..., None] * s
                 + jnp.einsum('bhsd,bhsv->bhdv', kb * jnp.exp(last - cum), vb))
        if not with_out:
            return s_new, None
        rel = jnp.where(lower, cum[:, :, :, None] - cum[:, :, None], -jnp.inf)
        scores = jnp.einsum('bhtd,bhsd,bhtsd->bhts', qb, kb, jnp.exp(rel))
        o = (jnp.einsum('bhts,bhsv->bhtv', scores, vb)
             + jnp.einsum('bhtd,bhdv->bhtv', qb * jnp.exp(cum), s))
        return s_new, o

    s_fin, o = lax.scan(step, s0, (blocks(q), blocks(k), blocks(v), blocks(log_f)))
    if not with_out:
        return None, s_fin
    return o.transpose(1, 0, 3, 2, 4).reshape(bsz, n, h, dv), s_fin


def gla_two_stream(q_c, v_c, kg_c, q_l, v_l, kg_l, ctx_out):
    s0 = jnp.zeros((q_c.shape[0], q_c.shape[2], q_c.shape[3], v_c.shape[3]), jnp.float32)
    o_c, o_l = 0.0, 0.0
    for dr in (0, 1):
        orient = flip_t if dr == 1 else (lambda t: t)
        k_c, g_c = kg_c[dr]
        k_l, g_l = kg_l[dr]
        oc, s_ctx = chunk_gla(orient(q_c), orient(k_c), orient(v_c), orient(g_c), s0, ctx_out)
        ol, _ = chunk_gla(orient(q_l), orient(k_l), orient(v_l), orient(g_l), s_ctx, True)
        o_l = o_l + orient(ol)
        if ctx_out:
            o_c = o_c + orient(oc)
    return (o_c if ctx_out else None), o_l


def hgrn_lower_bound(lb_logits, layer):
    cum = jnp.cumsum(jax.nn.softmax(lb_logits.astype(jnp.float32), axis=0), axis=0)
    return cum[layer] - cum[0]


def hgrn2_mixer(pc, pl, lbs, ctx_out):
    def prepare(p):
        bsz, n, _ = p[P_HG_Q].shape

        def heads(t):
            return t.astype(jnp.float32).reshape(bsz, n, HGRN_HEADS, HGRN_DIM)

        q = heads(p[P_HG_Q]) * HGRN_DIM ** -0.5
        v = jax.nn.silu(heads(p[P_HG_I]))
        kg = []
        for z, lb in zip((heads(p[P_HG_FF]), heads(p[P_HG_FB])), lbs):
            lb = lb.reshape(HGRN_HEADS, HGRN_DIM)
            f = lb + (1.0 - lb) * jax.nn.sigmoid(z)
            kg.append(((1.0 - lb) * jax.nn.sigmoid(-z), jnp.log(f)))
        return q, v, kg

    q_c, v_c, kg_c = prepare(pc)
    q_l, v_l, kg_l = prepare(pl)
    o_c, o_l = gla_two_stream(q_c, v_c, kg_c, q_l, v_l, kg_l, ctx_out)
    out_c = gated_head_norm(o_c, pc[P_HG_G]) if ctx_out else None
    return out_c, gated_head_norm(o_l, pl[P_HG_G])


def retention_log_decay(offset):
    return jnp.log1p(-jnp.exp2(-(offset + jnp.arange(RET_HEADS, dtype=jnp.float32))))


def axial_rotary(x):
    n = x.shape[1]
    rows = n // GRID_W
    row = jnp.repeat(jnp.arange(rows, dtype=jnp.float32), GRID_W)
    col = jnp.tile(jnp.arange(GRID_W, dtype=jnp.float32), rows)
    half = x.shape[-1] // 2
    quarter = half // 2
    inv_freq = ROPE_BASE ** (-jnp.arange(quarter, dtype=jnp.float32) / quarter)
    ang = jnp.concatenate([row[:, None] * inv_freq, col[:, None] * inv_freq], axis=-1)[None, :, None, :]
    cos, sin = jnp.cos(ang), jnp.sin(ang)
    x1, x2 = x[..., :half], x[..., half:]
    return jnp.concatenate([x1 * cos - x2 * sin, x1 * sin + x2 * cos], axis=-1)


def retention_mixer(pc, pl, ctx_out):
    def heads(t):
        bsz, n, _ = t.shape
        return t.astype(jnp.float32).reshape(bsz, n, RET_HEADS, RET_DIM)

    scale = RET_DIM ** -0.5
    q_c, k_c, v_c = heads(pc[P_RET_Q]), heads(pc[P_RET_K]) * scale, heads(pc[P_RET_V])
    q_l = axial_rotary(heads(pl[P_RET_Q]))
    k_l = axial_rotary(heads(pl[P_RET_K])) * scale
    v_l = heads(pl[P_RET_V])
    decays = (retention_log_decay(RET_DECAY_EXP_FWD), retention_log_decay(RET_DECAY_EXP_BWD))
    kg_c = [(k_c, jnp.broadcast_to(dec[:, None], k_c.shape)) for dec in decays]
    kg_l = [(k_l, jnp.broadcast_to(dec[:, None], k_l.shape)) for dec in decays]
    o_c, o_l = gla_two_stream(q_c, v_c, kg_c, q_l, v_l, kg_l, ctx_out)
    out_c = gated_head_norm(o_c, pc[P_RET_G]) if ctx_out else None
    return out_c, gated_head_norm(o_l, pl[P_RET_G])


def moe_ffn(h, router_w, router_bias, w_gate, w_up, w_down):
    t = h.shape[0]
    scores = jax.nn.sigmoid(h.astype(jnp.float32) @ router_w.astype(jnp.float32))
    biased = scores + router_bias.astype(jnp.float32)
    grouped = biased.reshape(t, N_EXPERT_GROUPS, EXPERTS_PER_GROUP)
    group_score = jnp.sum(lax.top_k(grouped, TOP_K)[0], axis=-1)
    best = jnp.argmax(group_score, axis=-1)
    in_group = (jnp.arange(N_EXPERTS) // EXPERTS_PER_GROUP)[None, :] == best[:, None]
    _, idx = lax.top_k(jnp.where(in_group, biased, -jnp.inf), TOP_K)
    w = jnp.take_along_axis(scores, idx, axis=-1)
    w = w / jnp.sum(w, axis=-1, keepdims=True)
    gates = jnp.sum(jax.nn.one_hot(idx, N_EXPERTS, dtype=jnp.float32) * w[..., None], axis=1)
    y = jnp.zeros(h.shape, jnp.float32)
    for e in range(N_EXPERTS):
        he = jax.nn.silu(h @ w_gate[e]) * (h @ w_up[e])
        y = y + gates[:, e:e + 1] * (he @ w_down[e]).astype(jnp.float32)
    return y.astype(h.dtype)


def setup_inputs(seed: int = 0) -> dict:
    key = jax.random.key(seed)
    keys = iter(jax.random.split(key, 40))

    def normal(shape, scale):
        return jax.random.normal(next(keys), shape, jnp.float32) * scale

    def uniform(shape, lo, hi):
        return jax.random.uniform(next(keys), shape, jnp.float32, lo, hi)

    d, w, nl = D_MODEL, GROUP_WIDTH, DEPTH
    inp = {}
    inp['x'] = normal((BATCH, SEQ, d), 1.0)
    inp['c'] = normal((BATCH, d), 1.0)
    inp['ctx'] = normal((BATCH, CTX_LEN, d), 1.0)
    inp['c_ctx'] = normal((d,), 1.0)
    inp['norm_mix_g'] = 1.0 + normal((nl, d), 0.01)
    inp['norm_ffn_g'] = 1.0 + normal((nl, d), 0.01)
    inp['w_mod'] = normal((nl, d, 6 * d), 0.5 * d ** -0.5)
    inp['b_mod'] = normal((nl, 6 * d), 0.02)
    inp['w_in'] = normal((nl, d, N_IN_PARTS * w), d ** -0.5)
    inp['w_out'] = normal((nl, MIX_WIDTH, d), MIX_WIDTH ** -0.5)
    inp['s5_lam_re'] = -0.5 + normal((nl, 2, S5_GROUPS, S5_STATE), 0.01)
    inp['s5_lam_im'] = jnp.pi * jnp.arange(S5_STATE, dtype=jnp.float32) + normal((nl, 2, S5_GROUPS, S5_STATE), 0.01)
    inp['s5_log_dt'] = uniform((nl, 2, S5_GROUPS), math.log(S5_DT_MIN), math.log(S5_DT_MAX))
    inp['s5_b_re'] = normal((nl, 2, S5_GROUPS, S5_CH, S5_STATE), (2 * S5_CH) ** -0.5)
    inp['s5_b_im'] = normal((nl, 2, S5_GROUPS, S5_CH, S5_STATE), (2 * S5_CH) ** -0.5)
    inp['s5_c_re'] = normal((nl, 2, S5_GROUPS, S5_STATE, S5_CH), 0.5)
    inp['s5_c_im'] = normal((nl, 2, S5_GROUPS, S5_STATE, S5_CH), 0.5)
    inp['s5_d'] = normal((nl, w), 1.0)
    inp['s5_glu_w'] = normal((nl, w, w), w ** -0.5)
    inp['s5_glu_b'] = normal((nl, w), 0.01)
    inp['lru_conv_w'] = normal((nl, LRU_CONV, w), LRU_CONV ** -0.5)
    inp['lru_conv_b'] = normal((nl, w), 0.01)
    inp['lru_wa'] = normal((nl, 2, LRU_HEADS, LRU_HEAD_DIM, LRU_HEAD_DIM), LRU_HEAD_DIM ** -0.5)
    inp['lru_ba'] = normal((nl, 2, w), 0.01)
    inp['lru_wx'] = normal((nl, 2, LRU_HEADS, LRU_HEAD_DIM, LRU_HEAD_DIM), LRU_HEAD_DIM ** -0.5)
    inp['lru_bx'] = normal((nl, 2, w), 0.01)
    sig = uniform((nl, 2, w), 0.9, 0.999) ** (1.0 / LRU_C)
    inp['lru_lam'] = jnp.log(sig) - jnp.log1p(-sig)
    inp['hgrn_lb_logits'] = normal((2, nl, w), 1.0)
    inp['router_w'] = normal((d, N_EXPERTS), d ** -0.5)
    inp['router_bias'] = normal((N_EXPERTS,), 0.01)
    inp['moe_w_gate'] = normal((nl, N_EXPERTS, d, D_FF_EXPERT), d ** -0.5)
    inp['moe_w_up'] = normal((nl, N_EXPERTS, d, D_FF_EXPERT), d ** -0.5)
    inp['moe_w_down'] = normal((nl, N_EXPERTS, D_FF_EXPERT, d), D_FF_EXPERT ** -0.5)
    inp['final_norm_g'] = 1.0 + normal((d,), 0.01)
    return inp


def reference(x, c, ctx, c_ctx, norm_mix_g, norm_ffn_g, w_mod, b_mod, w_in, w_out,
              s5_lam_re, s5_lam_im, s5_log_dt, s5_b_re, s5_b_im, s5_c_re, s5_c_im, s5_d,
              s5_glu_w, s5_glu_b, lru_conv_w, lru_conv_b, lru_wa, lru_ba, lru_wx, lru_bx, lru_lam,
              hgrn_lb_logits, router_w, router_bias, moe_w_gate, moe_w_up, moe_w_down, final_norm_g):
    bsz, n, dm = x.shape
    dtype = x.dtype
    xl = x
    xc = ctx.astype(dtype)
    for layer in range(DEPTH):
        ctx_out = layer < DEPTH - 1
        mod_l = (jax.nn.silu(c) @ w_mod[layer] + b_mod[layer]).reshape(bsz, 6, 1, dm)
        mod_c = (jax.nn.silu(c_ctx) @ w_mod[layer] + b_mod[layer]).reshape(6, dm)

        hl = modulate(rms_norm(xl, norm_mix_g[layer]), mod_l[:, 0], mod_l[:, 1])
        hc = modulate(rms_norm(xc, norm_mix_g[layer]), mod_c[0], mod_c[1])
        pl = jnp.split(hl @ w_in[layer], N_IN_PARTS, axis=-1)
        pc = jnp.split(hc @ w_in[layer], N_IN_PARTS, axis=-1)
        a_c, a_l = s5_mixer(pc, pl, s5_lam_re[layer], s5_lam_im[layer], s5_log_dt[layer],
                            s5_b_re[layer], s5_b_im[layer], s5_c_re[layer], s5_c_im[layer],
                            s5_d[layer], s5_glu_w[layer], s5_glu_b[layer], ctx_out)
        b_c, b_l = rglru_mixer(pc, pl, lru_conv_w[layer], lru_conv_b[layer], lru_wa[layer],
                               lru_ba[layer], lru_wx[layer], lru_bx[layer], lru_lam[layer], ctx_out)
        lbs = (hgrn_lower_bound(hgrn_lb_logits[0], layer), hgrn_lower_bound(hgrn_lb_logits[1], layer))
        h_c, h_l = hgrn2_mixer(pc, pl, lbs, ctx_out)
        r_c, r_l = retention_mixer(pc, pl, ctx_out)
        mix_l = jnp.concatenate([a_l, b_l, h_l, r_l], axis=-1).astype(dtype) @ w_out[layer]
        xl = xl + mod_l[:, 2] * mix_l
        if ctx_out:
            mix_c = jnp.concatenate([a_c, b_c, h_c, r_c], axis=-1).astype(dtype) @ w_out[layer]
            xc = xc + mod_c[2] * mix_c

        hl = modulate(rms_norm(xl, norm_ffn_g[layer]), mod_l[:, 3], mod_l[:, 4])
        if ctx_out:
            hc = modulate(rms_norm(xc, norm_ffn_g[layer]), mod_c[3], mod_c[4])
            tokens = jnp.concatenate([hl.reshape(-1, dm), hc.reshape(-1, dm)], axis=0)
        else:
            tokens = hl.reshape(-1, dm)
        y = moe_ffn(tokens, router_w, router_bias, moe_w_gate[layer], moe_w_up[layer], moe_w_down[layer])
        xl = xl + mod_l[:, 5] * y[: bsz * n].reshape(bsz, n, dm)
        if ctx_out:
            xc = xc + mod_c[5] * y[bsz * n:].reshape(bsz, -1, dm)
    return rms_norm(xl, final_norm_g)
```

```cpp
#include <hip/hip_runtime.h>
#include <cstdio>
#include <cstdint>
__device__ __forceinline__ int tid_(int wv) { int l; asm volatile("v_mbcnt_lo_u32_b32 %0, -1, 0\n\tv_mbcnt_hi_u32_b32 %0, -1, %0" : "=v"(l)); return (wv << 6) | l; }
namespace pg8 {
#define PG8_LAS __attribute__((address_space(3)))
typedef unsigned short bf16_t;
typedef short bf16x8 __attribute__((ext_vector_type(8)));
typedef float f32x4 __attribute__((ext_vector_type(4)));
typedef unsigned u32x4 __attribute__((ext_vector_type(4)));
constexpr int BM = 256, BK = 64, HALF = 128, HTB = HALF * BK * 2  , STAGE_BYTES = 8 * HTB, NXCD = 8, WGM = 8;

__host__ __device__ __forceinline__ int lds_byte(int r, int c) { const int st = (r >> 4) * 2 + (c >> 5), rr = r & 15, cc = c & 31, ob = rr * 64 + cc * 2; return st * 1024 + (ob ^ (((ob >> 9) & 1) << 5)); }
__host__ __device__ __forceinline__ void stage_rc(int b, int& R, int& C) { const int st = b / 1024, sb = b % 1024, swz = sb ^ (((sb >> 9) & 1) << 5); R = (st >> 1) * 16 + swz / 64; C = (st & 1) * 32 + (swz % 64) / 2; }
__host__ __device__ __forceinline__ int perm32(int rho) { const int n = rho >> 4, i = rho & 15; return 8 * (i >> 2) + 4 * n + (i & 3); }

struct Unit { int pm, pn; };
struct Gemm { const bf16_t* A; const bf16_t* Bt; int M, N, K; };

struct StaticOrder {
    int nM, nN, nwg, G, c;
    __host__ __device__ void init(int M, int N, int G_, int c_) { nM = M / BM; nN = N / BM; nwg = nM * nN; G = G_; c = c_; }
    __host__ __device__ bool next(int i, Unit& u) const {
        const long L = (long)i * G + c; if (L >= nwg) return false;
        int wgid = (int)L; { const int q = nwg / NXCD, r = nwg % NXCD, xcd = wgid % NXCD, off = wgid / NXCD; wgid = (xcd < r ? xcd * (q + 1) : r * (q + 1) + (xcd - r) * q) + off; }
        const int nig = WGM * nN, gid = wgid / nig, fm = gid * WGM, gsz = (nM - fm) < WGM ? (nM - fm) : WGM;
        u.pm = fm + ((wgid % nig) % gsz); u.pn = (wgid % nig) / gsz; return true;
    }
    __device__ __forceinline__ void a_ready(const Unit&) const {}
    __device__ __forceinline__ void done(const Unit&) const {}
};
typedef __bf16 bf16x2_t_ __attribute__((ext_vector_type(2))); typedef float f32x2_ __attribute__((ext_vector_type(2)));
__device__ __forceinline__ unsigned cvt_pk_bf16(float lo, float hi) { const f32x2_ v = {lo, hi}; return __builtin_bit_cast(unsigned, __builtin_convertvector(v, bf16x2_t_)); }
template <class Epi, class Sched, bool ALIGN_EPI = false, bool SP2 = false, bool GATHER = false>
__device__ __forceinline__ void gemm_phase(PG8_LAS unsigned char* lds, const Gemm g, const Sched& S, const Epi& E, int wv, const PG8_LAS unsigned* gtab = nullptr) {
    const int tid = tid_(wv), wid = __builtin_amdgcn_readfirstlane(tid >> 6), lane = tid & 63, wr = wid >> 2, wc = wid & 3, fr = lane & 15, fq = lane >> 4;
    const int K = g.K, nt = K / BK;
    unsigned voffA[2], voffB[2];
#pragma unroll
    for (int i = 0; i < 2; ++i) { int R, C; stage_rc(tid * 16 + i * 8192, R, C); const int Rb = Epi::PERM ? ((R & ~31) + perm32(R & 31)) : R;
        voffA[i] = (unsigned)(R * K + C) * 2u; voffB[i] = (unsigned)(Rb * K + C) * 2u; }
    int gR[2]; unsigned gC[2];
#pragma unroll
    for (int i = 0; i < 2; ++i) { int R, C; stage_rc(tid * 16 + i * 8192, R, C); gR[i] = R; gC[i] = (unsigned)C * 2u; }
    unsigned vgC[2][2], vgN[2][2];
#define PG8_GOFFS(dst, uidx) do { _Pragma("unroll") for (int _h = 0; _h < 2; ++_h) _Pragma("unroll") for (int _i = 0; _i < 2; ++_i) dst[_h][_i] = gtab[(uidx) * 256 + 128 * _h + gR[_i]] + gC[_i]; } while (0)
#define PG8_STAGE_A(bufoff, gbase, h, nx) do { if constexpr (GATHER) { _Pragma("unroll") for (int _i = 0; _i < 2; ++_i) { const unsigned _o = (nx) ? vgN[h][_i] : vgC[h][_i]; \
        __builtin_amdgcn_global_load_lds((const unsigned*)((const char*)(gbase) + _o), (PG8_LAS unsigned*)(lds + (bufoff) + ldsw + _i * 8192), 16, 0, 0); } } \
        else { PG8_STAGE(bufoff, (gbase) + (h) * hstep, voffA); } } while (0)
    const size_t kstep = (size_t)(BK * 2);
    const size_t hstep = (size_t)HALF * K * 2;
    const size_t tstep = 2 * hstep;
    const unsigned ldsw = (unsigned)wid * 1024u;
    const int aoff = lds_byte(wr * 64 + fr, fq * 8), boff = lds_byte(wc * 32 + fr, fq * 8);
#define PG8_SA(b, h) (((b) * 2 + (h)) * HTB)
#define PG8_SB(b, h) ((4 + (b) * 2 + (h)) * HTB)
#define PG8_STAGE(bufoff, gbase, voff) do { _Pragma("unroll") for (int _i = 0; _i < 2; ++_i) \
        __builtin_amdgcn_global_load_lds((const unsigned*)((const char*)(gbase) + (voff)[_i]), (PG8_LAS unsigned*)(lds + (bufoff) + ldsw + _i * 8192), 16, 0, 0); } while (0)
#define PG8_LDA(dst, b, h) do { _Pragma("unroll") for (int m = 0; m < 4; ++m) _Pragma("unroll") for (int k = 0; k < 2; ++k) dst[m][k] = *(const PG8_LAS bf16x8*)(lds + PG8_SA(b, h) + aoff + m * 2048 + k * 1024); } while (0)
#define PG8_LDB(dst, b, h) do { _Pragma("unroll") for (int n = 0; n < 2; ++n) _Pragma("unroll") for (int k = 0; k < 2; ++k) dst[n][k] = *(const PG8_LAS bf16x8*)(lds + PG8_SB(b, h) + boff + n * 2048 + k * 1024); } while (0)
#define PG8_MMA(ai, bj, At, Bt) do { __builtin_amdgcn_s_setprio(1); _Pragma("unroll") for (int m = 0; m < 4; ++m) _Pragma("unroll") for (int n = 0; n < 2; ++n) _Pragma("unroll") for (int k = 0; k < 2; ++k) \
        acc[ai][bj][m][n] = __builtin_amdgcn_mfma_f32_16x16x32_bf16(Bt[n][k], At[m][k], acc[ai][bj][m][n], 0, 0, 0); __builtin_amdgcn_s_setprio(0); } while (0)
#define PG8_WAIT_V(n) asm volatile("s_waitcnt vmcnt(" #n ")" ::: "memory")
#define PG8_WAIT_L(n) asm volatile("s_waitcnt lgkmcnt(" #n ")" ::: "memory")
#define PG8_BAR __builtin_amdgcn_s_barrier()
#define PG8_SCHED __builtin_amdgcn_sched_barrier(0)
    Unit cur, nxt; int ui = 0;
    if (!S.next(0, cur)) return;
    f32x4 acc[2][2][4][2];
#pragma unroll
    for (int a = 0; a < 2; ++a)
#pragma unroll
        for (int b = 0; b < 2; ++b)
#pragma unroll
            for (int m = 0; m < 4; ++m)
#pragma unroll
                for (int n = 0; n < 2; ++n) acc[a][b][m][n] = (f32x4){0.f, 0.f, 0.f, 0.f};
    bf16x8 At[4][2], B0[2][2], B1[2][2];
    const char* cA = (const char*)g.A + (GATHER ? (size_t)0 : (size_t)cur.pm * tstep); const char* cB = (const char*)g.Bt + (size_t)cur.pn * tstep;
    if constexpr (GATHER) PG8_GOFFS(vgC, 0);
    S.a_ready(cur);
    if constexpr (SP2) {
        PG8_STAGE(PG8_SB(0, 0), cB, voffB); PG8_STAGE(PG8_SB(0, 1), cB + hstep, voffB); PG8_STAGE_A(PG8_SA(0, 0), cA, 0, false); PG8_STAGE_A(PG8_SA(0, 1), cA, 1, false);
        if (wr == 1) PG8_BAR;
        PG8_WAIT_V(2); PG8_BAR;
        PG8_STAGE(PG8_SB(1, 0), cB + kstep, voffB); PG8_STAGE_A(PG8_SA(1, 0), cA + kstep, 0, false); PG8_STAGE(PG8_SB(1, 1), cB + hstep + kstep, voffB);
        PG8_WAIT_V(6); PG8_BAR;
    } else {
        PG8_STAGE(PG8_SB(0, 0), cB, voffB); PG8_STAGE_A(PG8_SA(0, 0), cA, 0, false); PG8_STAGE(PG8_SB(0, 1), cB + hstep, voffB); PG8_STAGE_A(PG8_SA(0, 1), cA, 1, false);
        if (wr == 1) PG8_BAR;
        PG8_WAIT_V(4); PG8_BAR;
        PG8_STAGE(PG8_SB(1, 0), cB + kstep, voffB); PG8_STAGE_A(PG8_SA(1, 0), cA + kstep, 0, false); PG8_STAGE(PG8_SB(1, 1), cB + hstep + kstep, voffB);
        PG8_WAIT_V(6); PG8_BAR;
    }
    for (;;) {
        const bool has_next = S.next(ui + 1, nxt);
        if constexpr (GATHER) { if (has_next) PG8_GOFFS(vgN, ui + 1); else { _Pragma("unroll") for (int _h = 0; _h < 2; ++_h) _Pragma("unroll") for (int _i = 0; _i < 2; ++_i) vgN[_h][_i] = vgC[_h][_i]; } }
        const char* nA = (has_next && !GATHER) ? (const char*)g.A + (size_t)nxt.pm * tstep : cA; const char* nB = has_next ? (const char*)g.Bt + (size_t)nxt.pn * tstep : cB;
        for (int t = 0; t < nt; t += 2) {
            const bool last = (t == nt - 2);
            const char* a1 = cA + (size_t)(t + 1) * kstep;
            const char* a2 = last ? nA : cA + (size_t)(t + 2) * kstep; const char* b2 = last ? nB : cB + (size_t)(t + 2) * kstep;
            const char* a3 = a2 + kstep; const char* b3 = b2 + kstep;
            if (last && has_next) S.a_ready(nxt);
            if constexpr (SP2) {
            PG8_LDB(B0, 0, 0); PG8_LDB(B1, 0, 1); PG8_SCHED; PG8_LDA(At, 0, 0); PG8_STAGE_A(PG8_SA(1, 1), a1, 1, false);
            PG8_WAIT_V(8); PG8_WAIT_L(0); PG8_BAR; PG8_MMA(0, 0, At, B0); PG8_MMA(0, 1, At, B1); PG8_BAR; PG8_SCHED;
            PG8_LDA(At, 0, 1); PG8_STAGE(PG8_SB(0, 0), b2, voffB); PG8_STAGE(PG8_SB(0, 1), b2 + hstep, voffB); PG8_STAGE_A(PG8_SA(0, 0), a2, 0, last);
            PG8_WAIT_V(8); PG8_WAIT_L(0); PG8_BAR; PG8_MMA(1, 0, At, B0); PG8_MMA(1, 1, At, B1); PG8_BAR; PG8_SCHED;
            PG8_LDB(B0, 1, 0); PG8_LDB(B1, 1, 1); PG8_SCHED; PG8_LDA(At, 1, 0); PG8_STAGE_A(PG8_SA(0, 1), a2, 1, last);
            PG8_WAIT_V(8); PG8_WAIT_L(0); PG8_BAR; PG8_MMA(0, 0, At, B0); PG8_MMA(0, 1, At, B1); PG8_BAR; PG8_SCHED;
            PG8_LDA(At, 1, 1); PG8_STAGE(PG8_SB(1, 0), b3, voffB); PG8_STAGE(PG8_SB(1, 1), b3 + hstep, voffB); PG8_STAGE_A(PG8_SA(1, 0), a3, 0, last);
            PG8_WAIT_V(8); PG8_WAIT_L(0); PG8_BAR; PG8_MMA(1, 0, At, B0); PG8_MMA(1, 1, At, B1); PG8_BAR; PG8_SCHED;
            } else {
            PG8_LDB(B0, 0, 0); PG8_SCHED; PG8_LDA(At, 0, 0); PG8_STAGE_A(PG8_SA(1, 1), a1, 1, false);
            PG8_WAIT_L(8); PG8_BAR; PG8_WAIT_L(0); PG8_MMA(0, 0, At, B0); PG8_BAR; PG8_SCHED;
            PG8_LDB(B1, 0, 1); PG8_STAGE(PG8_SB(0, 0), b2, voffB);
            PG8_BAR; PG8_WAIT_L(0); PG8_MMA(0, 1, At, B1); PG8_BAR;
            PG8_LDA(At, 0, 1); PG8_STAGE_A(PG8_SA(0, 0), a2, 0, last);
            PG8_BAR; PG8_WAIT_L(0); PG8_MMA(1, 0, At, B0); PG8_BAR; PG8_SCHED;
            PG8_STAGE(PG8_SB(0, 1), b2 + hstep, voffB);
            PG8_WAIT_V(6); PG8_BAR; PG8_MMA(1, 1, At, B1); PG8_BAR;
            PG8_LDB(B0, 1, 0); PG8_SCHED; PG8_LDA(At, 1, 0); PG8_STAGE_A(PG8_SA(0, 1), a2, 1, last);
            PG8_WAIT_L(8); PG8_BAR; PG8_WAIT_L(0); PG8_MMA(0, 0, At, B0); PG8_BAR; PG8_SCHED;
            PG8_LDB(B1, 1, 1); PG8_STAGE(PG8_SB(1, 0), b3, voffB);
            PG8_BAR; PG8_WAIT_L(0); PG8_MMA(0, 1, At, B1); PG8_BAR;
            PG8_LDA(At, 1, 1); PG8_STAGE_A(PG8_SA(1, 0), a3, 0, last);
            PG8_BAR; PG8_WAIT_L(0); PG8_MMA(1, 0, At, B0); PG8_BAR; PG8_SCHED;
            PG8_STAGE(PG8_SB(1, 1), b3 + hstep, voffB);
            PG8_WAIT_V(6); PG8_BAR; PG8_MMA(1, 1, At, B1); PG8_BAR;
            }
        }
        if constexpr (ALIGN_EPI) { if (wr == 0) PG8_BAR; }
        if constexpr (!Epi::AFTER_DRAIN) { E(acc, cur, wr, wc, fr, fq); S.done(cur); }
        if (!has_next) break;
#pragma unroll
        for (int a = 0; a < 2; ++a)
#pragma unroll
            for (int b = 0; b < 2; ++b)
#pragma unroll
                for (int m = 0; m < 4; ++m)
#pragma unroll
                    for (int n = 0; n < 2; ++n) acc[a][b][m][n] = (f32x4){0.f, 0.f, 0.f, 0.f};
        cur = nxt; cA = nA; cB = nB; ++ui;
        if constexpr (GATHER) { _Pragma("unroll") for (int _h = 0; _h < 2; ++_h) _Pragma("unroll") for (int _i = 0; _i < 2; ++_i) vgC[_h][_i] = vgN[_h][_i]; }
        if constexpr (ALIGN_EPI) { if (wr == 1) PG8_BAR; }
    }
    PG8_WAIT_V(0);
    if constexpr (!ALIGN_EPI) { if (wr == 0) PG8_BAR; }
    PG8_BAR;
    if constexpr (Epi::AFTER_DRAIN) { E.fused(acc, cur, wr, wc, fr, fq, lds, wid, lane); S.done(cur); }
#undef PG8_SA
#undef PG8_SB
#undef PG8_STAGE
#undef PG8_STAGE_A
#undef PG8_GOFFS
#undef PG8_LDA
#undef PG8_LDB
#undef PG8_MMA
#undef PG8_WAIT_V
#undef PG8_WAIT_L
#undef PG8_BAR
#undef PG8_SCHED
}
}
#define LAS __attribute__((address_space(3)))
typedef unsigned short bf16_t;
typedef float f32x4 __attribute__((ext_vector_type(4)));
typedef float f32x2 __attribute__((ext_vector_type(2)));
typedef unsigned u32x4 __attribute__((ext_vector_type(4)));
typedef unsigned u32x2 __attribute__((ext_vector_type(2)));

constexpr int NB = 16;
constexpr int SEQ = 2048, CTXL = 256, SCAN = SEQ + CTXL;
constexpr int DM = 2048;
constexpr int NLAT = NB * SEQ;
constexpr int NCTX = NB * CTXL;
constexpr int NTOK = NLAT + NCTX;
constexpr int NPC = 6144;
constexpr int GW = 512;
constexpr int NEXP = 16;
constexpr int DFF = 1024;
constexpr int MPAD = 2 * NTOK + NEXP * 256;
constexpr int NRCH = NTOK / 128;
constexpr float EPS = 1e-6f;

constexpr size_t al256(size_t x) { return (x + 255) & ~(size_t)255; }
constexpr size_t OFF_CTL = 0;
constexpr size_t CTL_BYTES = 65536;
constexpr size_t OFF_MOD = OFF_CTL + CTL_BYTES;
constexpr size_t OFF_LB = OFF_MOD + al256((size_t)2 * 17 * 12288 * 4);
constexpr size_t OFF_RE0 = OFF_LB + al256((size_t)2 * 2 * 512 * 4);
constexpr size_t OFF_RE1 = OFF_RE0 + (size_t)NTOK * 4;
constexpr size_t OFF_RW0 = OFF_RE1 + (size_t)NTOK * 4;
constexpr size_t OFF_RW1 = OFF_RW0 + (size_t)NTOK * 4;
constexpr size_t OFF_RP0 = OFF_RW1 + (size_t)NTOK * 4;
constexpr size_t OFF_RP1 = OFF_RP0 + (size_t)NTOK * 4;
constexpr size_t OFF_BLKCNT = OFF_RP1 + (size_t)NTOK * 4;
constexpr size_t OFF_SORTTOK = OFF_BLKCNT + al256((size_t)NRCH * 16 * 4);
constexpr size_t OFF_SORTGATE = OFF_SORTTOK + al256((size_t)MPAD * 4);
constexpr size_t OFF_TILE = OFF_SORTGATE + al256((size_t)MPAD * 4);
constexpr size_t OFF_WGLU = OFF_TILE + 2048;
constexpr size_t OFF_X = al256(OFF_WGLU + (size_t)2 * 512 * 512 * 2);
constexpr size_t OFF_HB = OFF_X + (size_t)NTOK * DM * 4;
constexpr size_t OFF_P = OFF_HB + (size_t)NTOK * DM * 2;
constexpr size_t P_REGION = (size_t)MPAD * DM * 2 + (size_t)MPAD * DFF * 2;
constexpr size_t OFF_YBUF = OFF_P;
constexpr size_t OFF_HE = OFF_P + (size_t)MPAD * DM * 2;
constexpr size_t OFF_WIN = OFF_P + P_REGION;
constexpr size_t OFF_WOUT = OFF_WIN + (size_t)2 * NPC * DM * 2;
constexpr size_t OFF_WMOE = OFF_WOUT + (size_t)2 * DM * DM * 2;
constexpr size_t OFF_W1 = OFF_WMOE;
constexpr size_t OFF_W2 = OFF_WMOE + (size_t)NEXP * 2048 * 2048 * 2;
constexpr size_t OFF_PB = OFF_WMOE + (size_t)NEXP * 2048 * 2048 * 2 + (size_t)NEXP * 2048 * 1024 * 2;
constexpr size_t OFF_GY = OFF_PB + (size_t)NTOK * DM * 2;
constexpr size_t WS_END = OFF_GY + (size_t)NTOK * 512 * 2;
static_assert((size_t)NTOK * NPC * 2 <= P_REGION, "P fits");

struct Params {
    const float *x, *c, *ctx, *c_ctx, *norm_mix_g, *norm_ffn_g, *w_mod, *b_mod, *w_in, *w_out;
    const float *s5_lam_re, *s5_lam_im, *s5_log_dt, *s5_b_re, *s5_b_im, *s5_c_re, *s5_c_im, *s5_d, *s5_glu_w, *s5_glu_b;
    const float *lru_conv_w, *lru_conv_b, *lru_wa, *lru_ba, *lru_wx, *lru_bx, *lru_lam, *hgrn_lb, *router_w, *router_bias;
    const float *moe_w_gate, *moe_w_up, *moe_w_down, *final_g;
    float* out; unsigned char* ws;
};

constexpr int PBLK = 128;
__device__ __forceinline__ size_t p_off(int row, int col) { return ((size_t)(col >> 7) * NTOK + (size_t)row) * PBLK + (col & 127); }
__device__ __forceinline__ float bf2f(unsigned v) { return __uint_as_float(v << 16); }
__device__ __forceinline__ float bflo(unsigned w) { return __uint_as_float(w << 16); }
__device__ __forceinline__ float bfhi(unsigned w) { return __uint_as_float(w & 0xffff0000u); }
typedef __bf16 bf16x2_c __attribute__((ext_vector_type(2)));
__device__ __forceinline__ unsigned pk2(float lo, float hi) { const f32x2 v = {lo, hi}; return __builtin_bit_cast(unsigned, __builtin_convertvector(v, bf16x2_c)); }
__device__ __forceinline__ unsigned f2bf(float f) { return pk2(f, f) & 0xffffu; }
__device__ __forceinline__ float frcp(float x) { return __builtin_amdgcn_rcpf(x); }
__device__ __forceinline__ float sigmoidf_(float x) { return frcp(1.0f + __expf(-x)); }
__device__ __forceinline__ float siluf_(float x) { return x * frcp(1.0f + __expf(-x)); }
__device__ __forceinline__ float geluf_(float x) {
    const float u = 0.7978845608028654f * (x + 0.044715f * x * x * x);
    return x * frcp(1.0f + __expf(-2.0f * u));
}
__device__ __forceinline__ float shx(float v, int mask, int lane) { return __int_as_float(__builtin_amdgcn_ds_bpermute((lane ^ mask) << 2, __float_as_int(v))); }
__device__ __forceinline__ float wave_sum(float v, int lane) {
#pragma unroll
    for (int o = 1; o < 64; o <<= 1) v += shx(v, o, lane);
    return v;
}
__device__ __forceinline__ float rdlane(float v, int l) { return __int_as_float(__builtin_amdgcn_readlane(__float_as_int(v), l)); }
__device__ __forceinline__ int scan_row(int b, int dir, int s) {
    if (s < CTXL) return NLAT + b * CTXL + (dir ? (CTXL - 1 - s) : s);
    const int l = s - CTXL; return b * SEQ + (dir ? (SEQ - 1 - l) : l);
}
__device__ __forceinline__ int mod_row(int row) { return row < NLAT ? (row >> 11) : 16; }
#define XB_TMO      128
#define XB_XCNT(j)  (256  + 64 * (j))
#define XB_XSUB(j)  (1280 + 64 * (j))
#define XB_XGEN(j)  (2304 + 64 * (j))
#define XB_TOP      3328
#define XB_TOPGEN   3392
#define XCD_BAR_WORDS 3456
#define XB_SPIN_CAP (1u << 18)

__device__ __forceinline__ unsigned xb_ld(unsigned* p)              { return __hip_atomic_load(p, __ATOMIC_RELAXED, __HIP_MEMORY_SCOPE_AGENT); }
__device__ __forceinline__ unsigned xb_add(unsigned* p, unsigned v) { return __hip_atomic_fetch_add(p, v, __ATOMIC_RELAXED, __HIP_MEMORY_SCOPE_AGENT); }
__device__ __forceinline__ unsigned xb_xcc_id() { return (unsigned)__builtin_amdgcn_s_getreg((3 << 11) | 20) & 0xFu; }
#define XB_SPIN(cond, bar) do { unsigned _sp = 0; while (cond) { __builtin_amdgcn_s_sleep(1); \
    if ((++_sp & 255u) == 0u) { if (xb_ld(&(bar)[XB_TMO])) break; if (_sp > XB_SPIN_CAP) { atomicAdd(&(bar)[XB_TMO], 1u); break; } } } } while (0)

struct XcdBarrier {
    unsigned* bar; unsigned x;
    volatile LAS unsigned* st;
};

__device__ __forceinline__ XcdBarrier xcd_barrier_post(unsigned* bar, volatile LAS unsigned* st) {
    XcdBarrier b; b.bar = bar; b.x = xb_xcc_id(); b.st = st;
    if (threadIdx.x == 0) (void)xb_add(&bar[XB_XCNT(b.x)], 1u);
    return b;
}
__device__ __forceinline__ void xcd_barrier_complete(unsigned* bar, unsigned x, unsigned& nloc, unsigned& nx) {
    const unsigned G = gridDim.x * gridDim.y * gridDim.z;
    unsigned sum, cnt, mine, sp = 0u;
    for (;;) {
        sum = 0u; cnt = 0u; mine = 0u;
#pragma unroll
        for (unsigned j = 0; j < 16; ++j) { const unsigned c = xb_ld(&bar[XB_XCNT(j)]); sum += c; cnt += (c > 0u) ? 1u : 0u; mine = (j == x) ? c : mine; }
        if (sum == G) break;
        __builtin_amdgcn_s_sleep(1);
        if ((++sp & 255u) == 0u) { if (xb_ld(&bar[XB_TMO])) break; if (sp > XB_SPIN_CAP) { atomicAdd(&bar[XB_TMO], 1u); break; } }
    }
    nloc = mine > 0u ? mine : 1u; nx = cnt > 0u ? cnt : 1u;
}

__device__ __forceinline__ void xcd_barrier(const XcdBarrier& b) {
    asm volatile("s_waitcnt vmcnt(0)" ::: "memory");
    __syncthreads();
    if (threadIdx.x == 0) {
        unsigned* bar = b.bar;
        __builtin_amdgcn_s_waitcnt(0);
        unsigned nloc = b.st[0], nx = b.st[1];
        if (nloc == 0u) { xcd_barrier_complete(bar, b.x, nloc, nx); b.st[0] = nloc; b.st[1] = nx; }
        const unsigned old = xb_add(&bar[XB_XSUB(b.x)], 1u);
        const unsigned gen = old / nloc;
        if (old + 1u == (gen + 1u) * nloc) {
            __builtin_amdgcn_fence(__ATOMIC_RELEASE, "agent");
            asm volatile("s_waitcnt vmcnt(0)" ::: "memory");
            const unsigned og = xb_add(&bar[XB_TOP], 1u);
            const unsigned tg = og / nx;
            if (og + 1u == (tg + 1u) * nx) xb_add(&bar[XB_TOPGEN], 1u);
            else XB_SPIN(xb_ld(&bar[XB_TOPGEN]) == tg, bar);
            __builtin_amdgcn_fence(__ATOMIC_ACQUIRE, "agent");
            xb_add(&bar[XB_XGEN(b.x)], 1u);
            asm volatile("s_waitcnt vmcnt(0)" ::: "memory");
        } else {
            XB_SPIN(xb_ld(&bar[XB_XGEN(b.x)]) == gen, bar);
            __builtin_amdgcn_fence(__ATOMIC_ACQUIRE, "agent");
            asm volatile("s_waitcnt vmcnt(0)" ::: "memory");
        }
    }
    __syncthreads();
}

namespace pg8 {
struct EpiPlainBf16 {
    static constexpr bool PERM = true, AFTER_DRAIN = false;
    bf16_t* O; int ldc; int silu_lo, silu_hi;
    __device__ __forceinline__ void operator()(const f32x4 (&acc)[2][2][4][2], const Unit& u, int wr, int wc, int fr, int fq) const {
        const int row0 = u.pm * BM + wr * 64 + fr, col0 = u.pn * BM + wc * 32 + 8 * fq;
        const bool act = u.pn >= silu_lo && u.pn < silu_hi;
#pragma unroll
        for (int ai = 0; ai < 2; ++ai)
#pragma unroll
            for (int m = 0; m < 4; ++m) { const int row = row0 + ai * HALF + m * 16;
                bf16_t* rowp = ldc ? O + (size_t)row * ldc + col0 : O + ((size_t)(2 * u.pn) * NTOK + row) * 128 + wc * 32 + 8 * fq;
                const size_t bjstep = ldc ? (size_t)HALF : (size_t)NTOK * 128;
#pragma unroll
                for (int bj = 0; bj < 2; ++bj) { f32x4 v0 = acc[ai][bj][m][0], v1 = acc[ai][bj][m][1];
                    if (act) { v0 = (f32x4){siluf_(v0[0]), siluf_(v0[1]), siluf_(v0[2]), siluf_(v0[3])}; v1 = (f32x4){siluf_(v1[0]), siluf_(v1[1]), siluf_(v1[2]), siluf_(v1[3])}; }
                    u32x4 w; w.x = cvt_pk_bf16(v0[0], v0[1]); w.y = cvt_pk_bf16(v0[2], v0[3]); w.z = cvt_pk_bf16(v1[0], v1[1]); w.w = cvt_pk_bf16(v1[2], v1[3]);
                    *(u32x4*)(rowp + bj * bjstep) = w; } }
    }
};
struct EpiResid {
    static constexpr bool PERM = true, AFTER_DRAIN = false;
    bf16_t* X; const float* gate; const float* xin; const float* cin;
    __device__ __forceinline__ void operator()(const f32x4 (&acc)[2][2][4][2], const Unit& u, int wr, int wc, int fr, int fq) const {
        const int row0 = u.pm * BM + wr * 64 + fr, col0 = u.pn * BM + wc * 32 + 8 * fq;
        const int bm = (u.pm < (NLAT / 256)) ? (u.pm >> 3) : 16;
        const float* gv = gate + (size_t)bm * 12288 + col0;
        const float* src = xin ? ((u.pm < (NLAT / 256)) ? xin + (size_t)row0 * DM : cin + (size_t)(row0 - NLAT) * DM) + col0 : nullptr;
        f32x4 g4[2][2];
#pragma unroll
        for (int bj = 0; bj < 2; ++bj)
#pragma unroll
            for (int n = 0; n < 2; ++n) g4[bj][n] = *(const f32x4*)(gv + bj * HALF + 4 * n);
#pragma unroll
        for (int ai = 0; ai < 2; ++ai)
#pragma unroll
            for (int m = 0; m < 4; ++m) { const size_t ro = (size_t)(ai * HALF + m * 16) * DM; bf16_t* xp = X + (size_t)row0 * DM + ro + col0;
#pragma unroll
                for (int bj = 0; bj < 2; ++bj) { f32x4 v0, v1;
                    if (src) { v0 = *(const f32x4*)(src + ro + bj * HALF); v1 = *(const f32x4*)(src + ro + bj * HALF + 4); }
                    else { const u32x4 w = *(const u32x4*)(xp + bj * HALF); v0 = (f32x4){bflo(w.x), bfhi(w.x), bflo(w.y), bfhi(w.y)}; v1 = (f32x4){bflo(w.z), bfhi(w.z), bflo(w.w), bfhi(w.w)}; }
                    v0 = v0 + g4[bj][0] * acc[ai][bj][m][0]; v1 = v1 + g4[bj][1] * acc[ai][bj][m][1];
                    u32x4 o; o.x = cvt_pk_bf16(v0[0], v0[1]); o.y = cvt_pk_bf16(v0[2], v0[3]); o.z = cvt_pk_bf16(v1[0], v1[1]); o.w = cvt_pk_bf16(v1[2], v1[3]);
                    *(u32x4*)(xp + bj * HALF) = o; } }
    }
};
struct EpiGlu {
    static constexpr bool PERM = true, AFTER_DRAIN = false;
    bf16_t* O; int ldo; const bf16_t* GY; const float* bias;
    __device__ __forceinline__ void operator()(const f32x4 (&acc)[2][2][4][2], const Unit& u, int wr, int wc, int fr, int fq) const {
        const int row0 = u.pm * BM + wr * 64 + fr, col0 = u.pn * BM + wc * 32 + 8 * fq;
        f32x4 bv[2][2];
#pragma unroll
        for (int bj = 0; bj < 2; ++bj)
#pragma unroll
            for (int n = 0; n < 2; ++n) bv[bj][n] = *(const f32x4*)(bias + col0 + bj * HALF + 4 * n);
#pragma unroll
        for (int ai = 0; ai < 2; ++ai)
#pragma unroll
            for (int m = 0; m < 4; ++m) { const int row = row0 + ai * HALF + m * 16;
#pragma unroll
                for (int bj = 0; bj < 2; ++bj) { const f32x4 v0 = acc[ai][bj][m][0] + bv[bj][0], v1 = acc[ai][bj][m][1] + bv[bj][1];
                    const u32x4 g = *(const u32x4*)(GY + (size_t)row * 512 + col0 + bj * HALF);
                    float o[8];
                    o[0] = bflo(g.x) * sigmoidf_(v0[0]); o[1] = bfhi(g.x) * sigmoidf_(v0[1]); o[2] = bflo(g.y) * sigmoidf_(v0[2]); o[3] = bfhi(g.y) * sigmoidf_(v0[3]);
                    o[4] = bflo(g.z) * sigmoidf_(v1[0]); o[5] = bfhi(g.z) * sigmoidf_(v1[1]); o[6] = bflo(g.w) * sigmoidf_(v1[2]); o[7] = bfhi(g.w) * sigmoidf_(v1[3]);
                    u32x4 w; w.x = cvt_pk_bf16(o[0], o[1]); w.y = cvt_pk_bf16(o[2], o[3]); w.z = cvt_pk_bf16(o[4], o[5]); w.w = cvt_pk_bf16(o[6], o[7]);
                    *(u32x4*)(O + (size_t)row * ldo + col0 + bj * HALF) = w; } }
    }
};
struct EpiSwiGlu {
    static constexpr bool PERM = true, AFTER_DRAIN = false;
    bf16_t* HE;
    __device__ __forceinline__ void operator()(const f32x4 (&acc)[2][2][4][2], const Unit& u, int wr, int wc, int fr, int fq) const {
        const int row0 = u.pm * BM + wr * 64 + fr, col0 = (u.pn & 7) * HALF + wc * 32 + 8 * fq;
#pragma unroll
        for (int ai = 0; ai < 2; ++ai)
#pragma unroll
            for (int m = 0; m < 4; ++m) { const int row = row0 + ai * HALF + m * 16;
                const f32x4 g0 = acc[ai][0][m][0], g1 = acc[ai][0][m][1], u0 = acc[ai][1][m][0], u1 = acc[ai][1][m][1];
                u32x4 w;
                w.x = cvt_pk_bf16(siluf_(g0[0]) * u0[0], siluf_(g0[1]) * u0[1]); w.y = cvt_pk_bf16(siluf_(g0[2]) * u0[2], siluf_(g0[3]) * u0[3]);
                w.z = cvt_pk_bf16(siluf_(g1[0]) * u1[0], siluf_(g1[1]) * u1[1]); w.w = cvt_pk_bf16(siluf_(g1[2]) * u1[2], siluf_(g1[3]) * u1[3]);
                *(u32x4*)(HE + (size_t)row * DFF + col0) = w; }
    }
};
struct EpiScaleRow {
    static constexpr bool PERM = true, AFTER_DRAIN = false;
    bf16_t* YB; const float* rowgate;
    __device__ __forceinline__ void operator()(const f32x4 (&acc)[2][2][4][2], const Unit& u, int wr, int wc, int fr, int fq) const {
        const int row0 = u.pm * BM + wr * 64 + fr, col0 = (u.pn & 7) * BM + wc * 32 + 8 * fq;
#pragma unroll
        for (int ai = 0; ai < 2; ++ai)
#pragma unroll
            for (int m = 0; m < 4; ++m) { const int row = row0 + ai * HALF + m * 16; const float rg = rowgate[row];
#pragma unroll
                for (int bj = 0; bj < 2; ++bj) { const f32x4 v0 = acc[ai][bj][m][0] * rg, v1 = acc[ai][bj][m][1] * rg;
                    u32x4 w; w.x = cvt_pk_bf16(v0[0], v0[1]); w.y = cvt_pk_bf16(v0[2], v0[3]); w.z = cvt_pk_bf16(v1[0], v1[1]); w.w = cvt_pk_bf16(v1[2], v1[3]);
                    *(u32x4*)(YB + (size_t)row * DM + col0 + bj * HALF) = w; } }
    }
};
struct MoeOrder {
    const int* tile_e; int ntiles, G, c;
    __device__ __forceinline__ bool next(int i, Unit& u) const {
        const long L = (long)i * G + c; const int nwg = ntiles * 8; if (L >= nwg) return false;
        int wgid = (int)L; { const int q = nwg / NXCD, r = nwg % NXCD, xcd = wgid % NXCD, off = wgid / NXCD; wgid = (xcd < r ? xcd * (q + 1) : r * (q + 1) + (xcd - r) * q) + off; }
        const int t = wgid >> 3; u.pm = t; u.pn = tile_e[t] * 8 + (wgid & 7); return true;
    }
    __device__ __forceinline__ void a_ready(const Unit&) const {}
    __device__ __forceinline__ void done(const Unit&) const {}
};
struct InOrderLast {
    StaticOrder lat; int G, c;
    __device__ __forceinline__ void init(int G_, int c_) { lat.init(NLAT, NPC, G_, c_); G = G_; c = c_; }
    __device__ __forceinline__ bool next(int i, Unit& u) const {
        const long L = (long)i * G + c; const int nlat = (NLAT / BM) * (NPC / BM);
        if (L < nlat) return lat.next(i, u);
        const int idx = (int)(L - nlat); if (idx >= (NCTX / BM) * 14) return false;
        const int k = idx % 14, sec = k >> 1;
        const int part = sec == 0 ? 0 : sec == 1 ? 1 : sec == 2 ? 4 : sec == 3 ? 5 : sec == 4 ? 6 : sec == 5 ? 9 : 10;
        u.pm = NLAT / BM + idx / 14; u.pn = part * 2 + (k & 1); return true;
    }
    __device__ __forceinline__ void a_ready(const Unit&) const {}
    __device__ __forceinline__ void done(const Unit&) const {}
};
}
#define WS_PTR(T, off) ((T*)(P.ws + (off)))

__device__ __forceinline__ void phase_mod(const Params& P, int l0, int l1, LAS unsigned char* lds, int bid, int nblk, int wv) {
    const int tid = tid_(wv);
    LAS float* sc = (LAS float*)lds;
    float* MOD = WS_PTR(float, OFF_MOD);
    if (bid == 0 && l0 == 0) {
        float* LB = WS_PTR(float, OFF_LB);
        for (int i = tid; i < 2 * 512; i += 512) { const int dir = i >> 9, ch = i & 511;
            const float l0 = P.hgrn_lb[(dir * 2 + 0) * 512 + ch], l1 = P.hgrn_lb[(dir * 2 + 1) * 512 + ch];
            LB[(0 * 2 + dir) * 512 + ch] = 0.f; LB[(1 * 2 + dir) * 512 + ch] = 1.0f / (1.0f + expf(l0 - l1)); }
    }
    for (int unit = l0 * 48 + bid; unit < l1 * 48; unit += nblk) {
        const int layer = unit / 48, cb = (unit % 48) * 256;
        __syncthreads();
        for (int i = tid; i < 17 * 2048; i += 512) { const int r = i >> 11, k = i & 2047; const float v = r < 16 ? P.c[r * 2048 + k] : P.c_ctx[k]; sc[i] = v / (1.0f + expf(-v)); }
        __syncthreads();
        const int lane = tid & 63, w = tid >> 6;
        f32x4 acc[17];
#pragma unroll
        for (int r = 0; r < 17; ++r) acc[r] = (f32x4){0.f, 0.f, 0.f, 0.f};
        const float* wp = P.w_mod + ((size_t)layer * 2048 + w * 256) * 12288 + cb + 4 * lane;
        for (int k8 = 0; k8 < 256; k8 += 8) {
            f32x4 wv_[8];
#pragma unroll
            for (int u = 0; u < 8; ++u) wv_[u] = *(const f32x4*)(wp + (size_t)(k8 + u) * 12288);
#pragma unroll
            for (int u4 = 0; u4 < 8; u4 += 4) {
#pragma unroll
                for (int r = 0; r < 17; ++r) { const f32x4 s4 = *(const LAS f32x4*)(sc + r * 2048 + w * 256 + k8 + u4);
                    acc[r] += wv_[u4] * s4[0] + wv_[u4 + 1] * s4[1] + wv_[u4 + 2] * s4[2] + wv_[u4 + 3] * s4[3]; }
            }
        }
        __syncthreads();
        LAS f32x4* red = (LAS f32x4*)lds;
#pragma unroll
        for (int r = 0; r < 17; ++r) red[(w * 17 + r) * 64 + lane] = acc[r];
        __syncthreads();
        for (int i = tid; i < 17 * 64; i += 512) { const int r = i >> 6, l4 = i & 63; f32x4 sum = red[(0 * 17 + r) * 64 + l4];
#pragma unroll
            for (int ww = 1; ww < 8; ++ww) sum += red[(ww * 17 + r) * 64 + l4];
            const f32x4 bm4 = *(const f32x4*)(P.b_mod + layer * 12288 + cb + 4 * l4);
            *(f32x4*)(MOD + ((size_t)layer * 17 + r) * 12288 + cb + 4 * l4) = sum + bm4; }
    }
    __syncthreads();
}

__device__ __forceinline__ void transpose_item(const float* W, int N, int k0, int n0, bf16_t* WT, int K, int drow0, LAS float* scr, int lane) {
    f32x4 v[8];
#pragma unroll
    for (int i = 0; i < 8; ++i) v[i] = *(const f32x4*)(W + (size_t)(k0 + 8 * i + (lane >> 3)) * N + n0 + 4 * (lane & 7));
#pragma unroll
    for (int i = 0; i < 8; ++i) { LAS float* d = scr + (8 * i + (lane >> 3)) * 33 + 4 * (lane & 7); d[0] = v[i][0]; d[1] = v[i][1]; d[2] = v[i][2]; d[3] = v[i][3]; }
    asm volatile("s_waitcnt lgkmcnt(0)" ::: "memory");
    const int c = lane & 7;
#pragma unroll
    for (int j = 0; j < 4; ++j) { const int n = (lane >> 3) + 8 * j; const LAS float* s = scr + (8 * c) * 33 + n;
        u32x4 o; o.x = pk2(s[0 * 33], s[1 * 33]); o.y = pk2(s[2 * 33], s[3 * 33]); o.z = pk2(s[4 * 33], s[5 * 33]); o.w = pk2(s[6 * 33], s[7 * 33]);
        *(u32x4*)(WT + (size_t)(drow0 + n) * K + k0 + 8 * c) = o; }
    asm volatile("s_waitcnt lgkmcnt(0)" ::: "memory");
}
__device__ __forceinline__ void phase_convert_small(const Params& P, int l0, int l1, LAS unsigned char* lds, int bid, int nblk, int wv) {
    const int tid = tid_(wv), lane = tid & 63, wave = __builtin_amdgcn_readfirstlane(tid >> 6);
    LAS float* scr = (LAS float*)(lds + wave * 16384);
    constexpr int I_IN = 32 * 192, I_OUT = 32 * 64, I_GLU = 8 * 16, I_L = I_IN + I_OUT + I_GLU;
    for (int it = l0 * I_L + bid * 8 + wave; it < l1 * I_L; it += nblk * 8) {
        const int layer = it / I_L; int r = it % I_L;
        if (r < I_IN) { const int kb = r / 192, nb = r % 192; transpose_item(P.w_in + (size_t)layer * DM * NPC, NPC, 64 * kb, 32 * nb, WS_PTR(bf16_t, OFF_WIN) + (size_t)layer * NPC * DM, DM, 32 * nb, scr, lane); continue; }
        r -= I_IN;
        if (r < I_OUT) { const int kb = r / 64, nb = r % 64; transpose_item(P.w_out + (size_t)layer * DM * DM, DM, 64 * kb, 32 * nb, WS_PTR(bf16_t, OFF_WOUT) + (size_t)layer * DM * DM, DM, 32 * nb, scr, lane); continue; }
        r -= I_OUT;
        { const int kb = r / 16, nb = r % 16; transpose_item(P.s5_glu_w + (size_t)layer * 512 * 512, 512, 64 * kb, 32 * nb, WS_PTR(bf16_t, OFF_WGLU) + (size_t)layer * 512 * 512, 512, 32 * nb, scr, lane); }
    }
}
struct TItem { const float* W; int N, k0, n0; bf16_t* WT; int K, drow0; };
__device__ __forceinline__ void titem_load(const TItem& t, int lane, f32x4 (&v)[8]) {
#pragma unroll
    for (int i = 0; i < 8; ++i) v[i] = __builtin_nontemporal_load((const f32x4*)(t.W + (size_t)(t.k0 + 8 * i + (lane >> 3)) * t.N + t.n0 + 4 * (lane & 7)));
}
__device__ __forceinline__ void titem_store(const TItem& t, LAS float* scr, int lane, const f32x4 (&v)[8]) {
#pragma unroll
    for (int i = 0; i < 8; ++i) { LAS float* d = scr + (8 * i + (lane >> 3)) * 33 + 4 * (lane & 7); d[0] = v[i][0]; d[1] = v[i][1]; d[2] = v[i][2]; d[3] = v[i][3]; }
    asm volatile("s_waitcnt lgkmcnt(0)" ::: "memory");
    const int c = lane & 7;
#pragma unroll
    for (int j = 0; j < 4; ++j) { const int n = (lane >> 3) + 8 * j; const LAS float* s = scr + (8 * c) * 33 + n;
        u32x4 o; o.x = pk2(s[0 * 33], s[1 * 33]); o.y = pk2(s[2 * 33], s[3 * 33]); o.z = pk2(s[4 * 33], s[5 * 33]); o.w = pk2(s[6 * 33], s[7 * 33]);
        *(u32x4*)(t.WT + (size_t)(t.drow0 + n) * t.K + t.k0 + 8 * c) = o; }
    asm volatile("s_waitcnt lgkmcnt(0)" ::: "memory");
}
__device__ __forceinline__ TItem moe_item(const Params& P, int layer, int it) {
    constexpr int I_G = 32 * 32, I_E = 3 * I_G;
    const int e = it / I_E; int r = it % I_E; TItem t;
    if (r < 2 * I_G) { const int up = r / I_G; r %= I_G; const int kb = r / 32, nb = r % 32, n0 = 32 * nb;
        t.W = (up ? P.moe_w_up : P.moe_w_gate) + ((size_t)layer * NEXP + e) * DM * DFF; t.N = DFF; t.k0 = 64 * kb; t.n0 = n0;
        t.WT = WS_PTR(bf16_t, OFF_W1) + (size_t)e * 2048 * 2048; t.K = DM; t.drow0 = (n0 >> 7) * 256 + up * 128 + (n0 & 127);
    } else { r -= 2 * I_G; const int kb = r / 64, nb = r % 64;
        t.W = P.moe_w_down + ((size_t)layer * NEXP + e) * DFF * DM; t.N = DM; t.k0 = 64 * kb; t.n0 = 32 * nb;
        t.WT = WS_PTR(bf16_t, OFF_W2) + (size_t)e * 2048 * 1024; t.K = DFF; t.drow0 = 32 * nb; }
    return t;
}
__device__ __forceinline__ void convert_moe_queue(const Params& P, int layer, LAS float* scr, LAS int* cq, int bid, int nblk, int lane) {
    constexpr int NIT = NEXP * 3 * 32 * 32;
    auto grab = [&]() { int k = 0; if (lane == 0) k = atomicAdd((int*)cq, 1); k = __builtin_amdgcn_readfirstlane(k); return (2 * k) * nblk + bid; };
    auto second = [&](int it) { return it + nblk < NIT ? it + nblk : it; };
    int it = grab(); if (it >= NIT) return;
    f32x4 va[8], vb[8], vc[8], vd[8];
    TItem ta = moe_item(P, layer, it), tb = moe_item(P, layer, second(it));
    titem_load(ta, lane, va); titem_load(tb, lane, vb);
    for (;;) {
        const int it2 = grab(); const bool ok2 = it2 < NIT; const int i2 = ok2 ? it2 : it;
        const TItem tc = moe_item(P, layer, i2), td = moe_item(P, layer, second(i2));
        titem_load(tc, lane, vc); titem_load(td, lane, vd);
        titem_store(ta, scr, lane, va); titem_store(tb, scr, lane, vb);
        if (!ok2) break;
        const int it3 = grab(); const bool ok3 = it3 < NIT; const int i3 = ok3 ? it3 : it2;
        ta = moe_item(P, layer, i3); tb = moe_item(P, layer, second(i3));
        titem_load(ta, lane, va); titem_load(tb, lane, vb);
        titem_store(tc, scr, lane, vc); titem_store(td, scr, lane, vd);
        if (!ok3) break;
        it = it3;
    }
}

__device__ __forceinline__ f32x4 ldx4(const bf16_t* p) { const u32x2 w = *(const u32x2*)p; return (f32x4){bflo(w.x), bfhi(w.x), bflo(w.y), bfhi(w.y)}; }
__device__ __forceinline__ void add_moe_rows(const Params& P, int pl, int row, int p0, int p1, int lane, f32x4 (&xv)[8]) {
    const bf16_t* y0 = WS_PTR(const bf16_t, OFF_YBUF) + (size_t)p0 * DM, *y1 = WS_PTR(const bf16_t, OFF_YBUF) + (size_t)p1 * DM;
    const float* g5 = WS_PTR(const float, OFF_MOD) + ((size_t)pl * 17 + mod_row(row)) * 12288 + 5 * 2048;
    u32x2 a[8], b[8];
#pragma unroll
    for (int j = 0; j < 8; ++j) { a[j] = *(const u32x2*)(y0 + 4 * lane + 256 * j); b[j] = *(const u32x2*)(y1 + 4 * lane + 256 * j); }
#pragma unroll
    for (int j = 0; j < 8; ++j) { const f32x4 g = *(const f32x4*)(g5 + 4 * lane + 256 * j);
        xv[j][0] += g[0] * (bflo(a[j].x) + bflo(b[j].x)); xv[j][1] += g[1] * (bfhi(a[j].x) + bfhi(b[j].x)); xv[j][2] += g[2] * (bflo(a[j].y) + bflo(b[j].y)); xv[j][3] += g[3] * (bfhi(a[j].y) + bfhi(b[j].y)); }
}
__device__ __forceinline__ void add_moe_out(const Params& P, int pl, int row, int lane, f32x4 (&xv)[8]) {
    const int p0 = __builtin_amdgcn_readfirstlane(WS_PTR(const int, OFF_RP0)[row]), p1 = __builtin_amdgcn_readfirstlane(WS_PTR(const int, OFF_RP1)[row]);
    add_moe_rows(P, pl, row, p0, p1, lane, xv);
}
__device__ __forceinline__ float row_rstd(const f32x4 (&xv)[8], int lane) {
    float s = 0.f;
#pragma unroll
    for (int j = 0; j < 8; ++j) s += (xv[j][0] * xv[j][0] + xv[j][1] * xv[j][1]) + (xv[j][2] * xv[j][2] + xv[j][3] * xv[j][3]);
    return rsqrtf(wave_sum(s, lane) * (1.0f / DM) + EPS);
}

__device__ __forceinline__ void phase_norm1(const Params& P, int layer, int bid, int nblk, int wv) {
    const int tid = tid_(wv), lane = tid & 63, wave = __builtin_amdgcn_readfirstlane(tid >> 6);
    bf16_t* X = WS_PTR(bf16_t, OFF_X); bf16_t* HB = WS_PTR(bf16_t, OFF_HB);
    const float* gmix = P.norm_mix_g + layer * DM;
    for (int r0 = 2 * (bid * 8 + wave); r0 < NTOK; r0 += nblk * 16) {
        f32x4 xv[2][8];
#pragma unroll
        for (int u = 0; u < 2; ++u) { const int row = r0 + u;
            if (layer == 0) { const float* src = row < NLAT ? P.x + (size_t)row * DM : P.ctx + (size_t)(row - NLAT) * DM;
#pragma unroll
                for (int j = 0; j < 8; ++j) xv[u][j] = *(const f32x4*)(src + 4 * lane + 256 * j); }
            else {
#pragma unroll
                for (int j = 0; j < 8; ++j) xv[u][j] = ldx4(X + (size_t)row * DM + 4 * lane + 256 * j); } }
        if (layer > 0) {
            const int pa0 = WS_PTR(const int, OFF_RP0)[r0], pa1 = WS_PTR(const int, OFF_RP1)[r0], pb0 = WS_PTR(const int, OFF_RP0)[r0 + 1], pb1 = WS_PTR(const int, OFF_RP1)[r0 + 1];
            add_moe_rows(P, layer - 1, r0, __builtin_amdgcn_readfirstlane(pa0), __builtin_amdgcn_readfirstlane(pa1), lane, xv[0]);
            add_moe_rows(P, layer - 1, r0 + 1, __builtin_amdgcn_readfirstlane(pb0), __builtin_amdgcn_readfirstlane(pb1), lane, xv[1]);
        }
        const float* md = WS_PTR(const float, OFF_MOD) + ((size_t)layer * 17 + mod_row(r0)) * 12288;
#pragma unroll
        for (int u = 0; u < 2; ++u) { const int row = r0 + u;
            if (layer > 0) {
#pragma unroll
                for (int j = 0; j < 8; ++j) { u32x2 w; w.x = pk2(xv[u][j][0], xv[u][j][1]); w.y = pk2(xv[u][j][2], xv[u][j][3]); *(u32x2*)(X + (size_t)row * DM + 4 * lane + 256 * j) = w; } }
            const float rstd = row_rstd(xv[u], lane);
#pragma unroll
            for (int j = 0; j < 8; ++j) { const int col = 4 * lane + 256 * j; const f32x4 g = *(const f32x4*)(gmix + col), sh = *(const f32x4*)(md + col), scl = *(const f32x4*)(md + 2048 + col);
                const f32x4 h = (xv[u][j] * rstd * g) * (scl + 1.0f) + sh;
                u32x2 w; w.x = pk2(h[0], h[1]); w.y = pk2(h[2], h[3]); *(u32x2*)(HB + (size_t)row * DM + col) = w; } }
    }
}

struct RCand { float v, s; int i; };
__device__ __forceinline__ RCand rsel(bool c, const RCand& x, const RCand& y) { RCand r; r.v = c ? x.v : y.v; r.s = c ? x.s : y.s; r.i = c ? x.i : y.i; return r; }
__device__ __forceinline__ void route_select(const float (&s)[16], const float (&bz)[16], int& e0, int& e1, float& w0, float& w1) {
    RCand bt, bs; float bg = 0.f;
#pragma unroll
    for (int g = 0; g < 4; ++g) {
        const RCand ca{bz[4 * g], s[4 * g], 4 * g}, cb{bz[4 * g + 1], s[4 * g + 1], 4 * g + 1}, cc{bz[4 * g + 2], s[4 * g + 2], 4 * g + 2}, cd{bz[4 * g + 3], s[4 * g + 3], 4 * g + 3};
        const bool b01 = cb.v > ca.v, b23 = cd.v > cc.v;
        const RCand m01 = rsel(b01, cb, ca), o01 = rsel(b01, ca, cb), m23 = rsel(b23, cd, cc), o23 = rsel(b23, cc, cd);
        const bool t23 = m23.v > m01.v;
        const RCand top = rsel(t23, m23, m01);
        const RCand sec01 = rsel(m23.v > o01.v, m23, o01);
        const RCand sec23 = rsel(o23.v > m01.v, o23, m01);
        const RCand sec = rsel(t23, sec23, sec01);
        const float gsc = top.v + sec.v;
        const bool better = (g == 0) || (gsc > bg);
        if (g == 0) { bt = top; bs = sec; bg = gsc; } else { bt = rsel(better, top, bt); bs = rsel(better, sec, bs); bg = better ? gsc : bg; }
    }
    const float inv = 1.0f / (bt.s + bs.s);
    e0 = bt.i; e1 = bs.i; w0 = bt.s * inv; w1 = bs.s * inv;
}
__device__ __forceinline__ void phase_norm2(const Params& P, int layer, int nch, int cr, LAS unsigned char* lds, int bid, int nblk, int wv) {
    const int tid = tid_(wv), lane = tid & 63, wave = __builtin_amdgcn_readfirstlane(tid >> 6);
    const bf16_t* X = WS_PTR(const bf16_t, OFF_X); bf16_t* HB = WS_PTR(bf16_t, OFF_HB);
    const float* gffn = P.norm_ffn_g + layer * DM;
    LAS f32x4* WL = (LAS f32x4*)lds;
    LAS int* cnt = (LAS int*)(lds + 131072);
    int* RE0 = WS_PTR(int, OFF_RE0); int* RE1 = WS_PTR(int, OFF_RE1); float* RW0 = WS_PTR(float, OFF_RW0); float* RW1 = WS_PTR(float, OFF_RW1);
    __syncthreads();
    for (int idx = tid; idx < 8192; idx += 512) { const int col = idx >> 2, eq = idx & 3; WL[eq * 2048 + (col & 3) * 512 + (col >> 2)] = *(const f32x4*)(P.router_w + (size_t)col * 16 + eq * 4); }
    const float rbias_l = P.router_bias[((((lane >> 4) & 1) << 3) | (((lane >> 3) & 1) << 2) | (((lane >> 2) & 1) << 1) | ((lane >> 1) & 1))];
    for (int ci = bid; ci < nch; ci += nblk) {
        __syncthreads();
        if (tid < 16) cnt[tid] = 0;
        __syncthreads();
        const int rpw = cr >> 3;
        const int npair = rpw >> 1;
        u32x2 ra[8], rb[8];
        { const bf16_t* xr = X + (size_t)(ci * cr + wave * rpw) * DM + 4 * lane;
#pragma unroll
          for (int j = 0; j < 8; ++j) { ra[j] = *(const u32x2*)(xr + 256 * j); rb[j] = *(const u32x2*)(xr + DM + 256 * j); } }
        for (int rr = 0; rr < npair; ++rr) {
            const int rowA = ci * cr + wave * rpw + 2 * rr, rowB = rowA + 1;
            f32x4 ha[8], hb[8];
#pragma unroll
            for (int j = 0; j < 8; ++j) { ha[j] = (f32x4){bflo(ra[j].x), bfhi(ra[j].x), bflo(ra[j].y), bfhi(ra[j].y)}; hb[j] = (f32x4){bflo(rb[j].x), bfhi(rb[j].x), bflo(rb[j].y), bfhi(rb[j].y)}; }
            const float rstdA = row_rstd(ha, lane), rstdB = row_rstd(hb, lane);
            const float* md = WS_PTR(const float, OFF_MOD) + ((size_t)layer * 17 + mod_row(rowA)) * 12288;
#pragma unroll
            for (int j = 0; j < 8; ++j) { const int col = 4 * lane + 256 * j; const f32x4 g = *(const f32x4*)(gffn + col), sh = *(const f32x4*)(md + 3 * 2048 + col), scl = *(const f32x4*)(md + 4 * 2048 + col);
                ha[j] = (ha[j] * rstdA * g) * (scl + 1.0f) + sh; hb[j] = (hb[j] * rstdB * g) * (scl + 1.0f) + sh;
                u32x2 wa; wa.x = pk2(ha[j][0], ha[j][1]); wa.y = pk2(ha[j][2], ha[j][3]); *(u32x2*)(HB + (size_t)rowA * DM + col) = wa;
                u32x2 wb; wb.x = pk2(hb[j][0], hb[j][1]); wb.y = pk2(hb[j][2], hb[j][3]); *(u32x2*)(HB + (size_t)rowB * DM + col) = wb; }
            { const int rn = rr + 1 < npair ? rowA + 2 : rowA;
              const bf16_t* xr = X + (size_t)rn * DM + 4 * lane;
#pragma unroll
              for (int j = 0; j < 8; ++j) { ra[j] = *(const u32x2*)(xr + 256 * j); rb[j] = *(const u32x2*)(xr + DM + 256 * j); } }
            f32x2 va[8], vb[8];
#pragma unroll
            for (int e = 0; e < 8; ++e) { va[e] = (f32x2){0.f, 0.f}; vb[e] = (f32x2){0.f, 0.f}; }
            f32x4 wq[4], wn[4];
#pragma unroll
            for (int eq = 0; eq < 4; ++eq) wq[eq] = WL[eq * 2048 + lane];
#pragma unroll
            for (int jq = 0; jq < 32; ++jq) { const int j = jq >> 2, q = jq & 3;
                if (jq + 1 < 32) { const int posn = ((jq + 1) & 3) * 512 + lane + 64 * ((jq + 1) >> 2);
#pragma unroll
                    for (int eq = 0; eq < 4; ++eq) wn[eq] = WL[eq * 2048 + posn]; }
                const f32x2 xa = (f32x2){ha[j][q], ha[j][q]}, xb = (f32x2){hb[j][q], hb[j][q]};
#pragma unroll
                for (int eq = 0; eq < 4; ++eq) { const f32x2 wlo = (f32x2){wq[eq][0], wq[eq][1]}, whi = (f32x2){wq[eq][2], wq[eq][3]};
                    va[2 * eq] += xa * wlo; va[2 * eq + 1] += xa * whi; vb[2 * eq] += xb * wlo; vb[2 * eq + 1] += xb * whi; }
#pragma unroll
                for (int eq = 0; eq < 4; ++eq) wq[eq] = wn[eq];
            }
            float v[32];
#pragma unroll
            for (int e = 0; e < 8; ++e) { v[2 * e] = va[e][0]; v[2 * e + 1] = va[e][1]; v[16 + 2 * e] = vb[e][0]; v[16 + 2 * e + 1] = vb[e][1]; }
#pragma unroll
            for (int st = 0; st < 5; ++st) { const int msk = 32 >> st, half = 16 >> st; const bool up = (lane & msk) != 0;
#pragma unroll
                for (int i = 0; i < half; ++i) { float lo = v[i], hi = v[i + half]; asm volatile("" : "+v"(lo), "+v"(hi));
                    const float keep = up ? hi : lo, send = up ? lo : hi; v[i] = keep + shx(send, msk, lane); } }
            v[0] += shx(v[0], 1, lane);
            const float mys = 1.0f / (1.0f + expf(-v[0])), mybz = mys + rbias_l;
            int e0, e1; float w0, w1;
            { float sA[16], zA[16];
#pragma unroll
              for (int i = 0; i < 16; ++i) { const int src = (((i >> 3) & 1) << 4) | (((i >> 2) & 1) << 3) | (((i >> 1) & 1) << 2) | ((i & 1) << 1); sA[i] = rdlane(mys, src); zA[i] = rdlane(mybz, src); }
              route_select(sA, zA, e0, e1, w0, w1); }
            if (lane == 0) { RE0[rowA] = e0; RE1[rowA] = e1; RW0[rowA] = w0; RW1[rowA] = w1; atomicAdd((int*)(cnt + e0), 1); atomicAdd((int*)(cnt + e1), 1); }
            { float sB[16], zB[16];
#pragma unroll
              for (int i = 0; i < 16; ++i) { const int src = 32 | (((i >> 3) & 1) << 4) | (((i >> 2) & 1) << 3) | (((i >> 1) & 1) << 2) | ((i & 1) << 1); sB[i] = rdlane(mys, src); zB[i] = rdlane(mybz, src); }
              route_select(sB, zB, e0, e1, w0, w1); }
            if (lane == 0) { RE0[rowB] = e0; RE1[rowB] = e1; RW0[rowB] = w0; RW1[rowB] = w1; atomicAdd((int*)(cnt + e0), 1); atomicAdd((int*)(cnt + e1), 1); }
        }
        __syncthreads();
        if (tid < 16) WS_PTR(int, OFF_BLKCNT)[ci * 16 + tid] = cnt[tid];
    }
    __syncthreads();
}

__device__ __forceinline__ void phase_route2(const Params& P, int nch, int cr, LAS unsigned char* lds, int bid, int nblk, int wv) {
    const int tid = tid_(wv);
    LAS int* sT = (LAS int*)lds;
    LAS int* sP = sT + 512;
    LAS int* sTot = sP + 512;
    LAS int* sPre = sTot + 16;
    LAS int* sSeg = sPre + 16;
    LAS int* sE0 = sSeg + 32;
    LAS int* sE1 = sE0 + 160;
    const int* BC = WS_PTR(const int, OFF_BLKCNT);
    int* ST = WS_PTR(int, OFF_SORTTOK); float* SG = WS_PTR(float, OFF_SORTGATE); int* TL = WS_PTR(int, OFF_TILE);
    for (int ci = bid; ci < nch; ci += nblk) {
        __syncthreads();
        { const int e = tid & 15, j = tid >> 4; int tot = 0, pre = 0;
          for (int c2 = j; c2 < nch; c2 += 32) { const int v = BC[c2 * 16 + e]; tot += v; if (c2 < ci) pre += v; }
          sT[j * 16 + e] = tot; sP[j * 16 + e] = pre; }
        __syncthreads();
        if (tid < 16) { int t = 0, p = 0; for (int j = 0; j < 32; ++j) { t += sT[j * 16 + tid]; p += sP[j * 16 + tid]; } sTot[tid] = t; sPre[tid] = p; }
        __syncthreads();
        if (tid == 0) { int off = 0; for (int e = 0; e < 16; ++e) { sSeg[e] = off; off += ((sTot[e] + 255) >> 8) << 8; } sSeg[16] = off; }
        if (tid < cr) { const int tok = ci * cr + tid; sE0[tid] = WS_PTR(const int, OFF_RE0)[tok]; sE1[tid] = WS_PTR(const int, OFF_RE1)[tok]; }
        __syncthreads();
        if (tid < cr) { const int tok = ci * cr + tid; const int e0 = sE0[tid], e1 = sE1[tid]; int r0 = 0, r1 = 0;
            for (int t2 = 0; t2 < tid; ++t2) { const int a = sE0[t2], b = sE1[t2]; r0 += (a == e0) + (b == e0); r1 += (a == e1) + (b == e1); }
            const int p0 = sSeg[e0] + sPre[e0] + r0, p1 = sSeg[e1] + sPre[e1] + r1;
            WS_PTR(int, OFF_RP0)[tok] = p0; WS_PTR(int, OFF_RP1)[tok] = p1;
            ST[p0] = tok; ST[p1] = tok; SG[p0] = WS_PTR(const float, OFF_RW0)[tok]; SG[p1] = WS_PTR(const float, OFF_RW1)[tok]; }
        if (ci == 0) {
            for (int e = 0; e < 16; ++e) { const int s0 = sSeg[e], s1 = sSeg[e + 1];
                for (int t = (s0 >> 8) + tid; t < (s1 >> 8); t += 512) TL[t] = e;
                for (int p = s0 + sTot[e] + tid; p < s1; p += 512) { ST[p] = -1; SG[p] = 0.f; } }
            if (tid == 0) TL[511] = sSeg[16] >> 8;
        }
    }
    __syncthreads();
}

__device__ __forceinline__ void phase_gather(const Params& P, int bid, int nblk, int wv) {
    const int tid = tid_(wv), lane = tid & 63, wave = __builtin_amdgcn_readfirstlane(tid >> 6);
    const int nrows = WS_PTR(const int, OFF_TILE)[511] * 256;
    const bf16_t* HB = WS_PTR(const bf16_t, OFF_HB); bf16_t* AS = WS_PTR(bf16_t, OFF_YBUF); const int* ST = WS_PTR(const int, OFF_SORTTOK);
    for (int p0 = 4 * (bid * 8 + wave); p0 < nrows; p0 += nblk * 32) {
        int tok[4];
#pragma unroll
        for (int u = 0; u < 4; ++u) tok[u] = ST[p0 + u];
        u32x4 v[4][4];
#pragma unroll
        for (int u = 0; u < 4; ++u)
#pragma unroll
            for (int j = 0; j < 4; ++j) v[u][j] = *(const u32x4*)(HB + (size_t)(tok[u] < 0 ? 0 : tok[u]) * DM + 8 * lane + 512 * j);
#pragma unroll
        for (int u = 0; u < 4; ++u)
#pragma unroll
            for (int j = 0; j < 4; ++j) *(u32x4*)(AS + (size_t)(p0 + u) * DM + 8 * lane + 512 * j) = tok[u] >= 0 ? v[u][j] : (u32x4){0u, 0u, 0u, 0u};
    }
}

__device__ __forceinline__ void ld8(const bf16_t* p, float (&o)[8]) { const u32x4 w = *(const u32x4*)p; o[0] = bflo(w.x); o[1] = bfhi(w.x); o[2] = bflo(w.y); o[3] = bfhi(w.y); o[4] = bflo(w.z); o[5] = bfhi(w.z); o[6] = bflo(w.w); o[7] = bfhi(w.w); }
__device__ __forceinline__ void st8(bf16_t* p, const float (&o)[8]) { u32x4 w; w.x = pk2(o[0], o[1]); w.y = pk2(o[2], o[3]); w.z = pk2(o[4], o[5]); w.w = pk2(o[6], o[7]); *(u32x4*)p = w; }
__device__ __forceinline__ void phase_finalize_s5(const Params& P, int layer, int nrows, int bid, int nblk, int wv) {
    const int tid = tid_(wv), lane = tid & 63, wave = __builtin_amdgcn_readfirstlane(tid >> 6);
    const bf16_t* HB = WS_PTR(const bf16_t, OFF_HB); const bf16_t* PB = WS_PTR(const bf16_t, OFF_PB); const bf16_t* PP = WS_PTR(const bf16_t, OFF_P); bf16_t* GY = WS_PTR(bf16_t, OFF_GY);
    const int c8 = 8 * lane;
    float dd[8];
#pragma unroll
    for (int q = 0; q < 8; ++q) dd[q] = P.s5_d[layer * 512 + c8 + q];
    for (int r0 = 4 * (bid * 8 + wave); r0 < nrows; r0 += nblk * 32) {
        u32x4 fa[4], fb[4], fg[4];
#pragma unroll
        for (int u = 0; u < 4; ++u) { const int row = r0 + u; fa[u] = *(const u32x4*)(HB + (size_t)row * DM + c8); fb[u] = *(const u32x4*)(PB + (size_t)row * DM + c8); fg[u] = *(const u32x4*)(PP + p_off(row, c8)); }
#pragma unroll
        for (int u = 0; u < 4; ++u) { float a[8], b[8], g[8], o[8];
#define UNPK(W_, A_) do { A_[0] = bflo(W_.x); A_[1] = bfhi(W_.x); A_[2] = bflo(W_.y); A_[3] = bfhi(W_.y); A_[4] = bflo(W_.z); A_[5] = bfhi(W_.z); A_[6] = bflo(W_.w); A_[7] = bfhi(W_.w); } while (0)
            UNPK(fa[u], a); UNPK(fb[u], b); UNPK(fg[u], g);
#pragma unroll
            for (int q = 0; q < 8; ++q) o[q] = geluf_(dd[q] * g[q] + a[q] + b[q]);
            st8(GY + (size_t)(r0 + u) * 512 + c8, o); }
    }
}
__device__ __forceinline__ void phase_finalize_rest(const Params& P, int layer, int nrows, int bid, int nblk, int wv) {
    const int tid = tid_(wv), lane = tid & 63, wave = __builtin_amdgcn_readfirstlane(tid >> 6);
    bf16_t* HB = WS_PTR(bf16_t, OFF_HB); const bf16_t* PB = WS_PTR(const bf16_t, OFF_PB); const bf16_t* PP = WS_PTR(const bf16_t, OFF_P);
    const int c8 = 8 * lane;
    for (int row = bid * 8 + wave; row < nrows; row += nblk * 8) {
        bf16_t* hb = HB + (size_t)row * DM; const bf16_t* pb = PB + (size_t)row * DM;
        u32x4 fa[4], fb[4], fg[4];
#pragma unroll
        for (int sct = 1; sct < 4; ++sct) { fa[sct] = *(const u32x4*)(hb + sct * 512 + c8); fb[sct] = *(const u32x4*)(pb + sct * 512 + c8); }
        fg[1] = *(const u32x4*)(PP + p_off(row, 2 * 512 + c8)); fg[2] = *(const u32x4*)(PP + p_off(row, 7 * 512 + c8)); fg[3] = *(const u32x4*)(PP + p_off(row, 11 * 512 + c8));
        float a[8], b[8], g[8], o[8];
        UNPK(fa[1], a); UNPK(fb[1], b); UNPK(fg[1], g);
#pragma unroll
        for (int q = 0; q < 8; ++q) o[q] = (a[q] + b[q]) * geluf_(g[q]);
        st8(hb + 512 + c8, o);
#pragma unroll
        for (int mx = 0; mx < 2; ++mx) {
            UNPK(fa[2 + mx], a); UNPK(fb[2 + mx], b); UNPK(fg[2 + mx], g);
            float ss = 0.f;
#pragma unroll
            for (int q = 0; q < 8; ++q) { a[q] += b[q]; ss += a[q] * a[q]; }
            ss += shx(ss, 1, lane); ss += shx(ss, 2, lane); ss += shx(ss, 4, lane); ss += shx(ss, 8, lane);
            const float rs = rsqrtf(ss * (1.0f / 128.0f) + EPS);
#pragma unroll
            for (int q = 0; q < 8; ++q) o[q] = a[q] * rs * siluf_(g[q]);
            st8(hb + 1024 + mx * 512 + c8, o);
        }
#undef UNPK
    }
}
__device__ __forceinline__ void phase_finalize(const Params& P, int layer, int nrows, int bid, int nblk, int wv) {
    const int tid = tid_(wv), lane = tid & 63, wave = __builtin_amdgcn_readfirstlane(tid >> 6);
    bf16_t* HB = WS_PTR(bf16_t, OFF_HB); const bf16_t* PB = WS_PTR(const bf16_t, OFF_PB); const bf16_t* PP = WS_PTR(const bf16_t, OFF_P); bf16_t* GY = WS_PTR(bf16_t, OFF_GY);
    const int c8 = 8 * lane;
    float dd[8];
#pragma unroll
    for (int q = 0; q < 8; ++q) dd[q] = P.s5_d[layer * 512 + c8 + q];
    for (int row = bid * 8 + wave; row < nrows; row += nblk * 8) {
        bf16_t* hb = HB + (size_t)row * DM; const bf16_t* pb = PB + (size_t)row * DM;
        u32x4 fa[4], fb[4], fg[4];
#pragma unroll
        for (int sct = 0; sct < 4; ++sct) { fa[sct] = *(const u32x4*)(hb + sct * 512 + c8); fb[sct] = *(const u32x4*)(pb + sct * 512 + c8); }
        fg[0] = *(const u32x4*)(PP + p_off(row, 0 * 512 + c8)); fg[1] = *(const u32x4*)(PP + p_off(row, 2 * 512 + c8)); fg[2] = *(const u32x4*)(PP + p_off(row, 7 * 512 + c8)); fg[3] = *(const u32x4*)(PP + p_off(row, 11 * 512 + c8));
        float a[8], b[8], g[8], o[8];
#define UNPK(W_, A_) do { A_[0] = bflo(W_.x); A_[1] = bfhi(W_.x); A_[2] = bflo(W_.y); A_[3] = bfhi(W_.y); A_[4] = bflo(W_.z); A_[5] = bfhi(W_.z); A_[6] = bflo(W_.w); A_[7] = bfhi(W_.w); } while (0)
        UNPK(fa[0], a); UNPK(fb[0], b); UNPK(fg[0], g);
#pragma unroll
        for (int q = 0; q < 8; ++q) o[q] = geluf_(dd[q] * g[q] + a[q] + b[q]);
        st8(GY + (size_t)row * 512 + c8, o);
        UNPK(fa[1], a); UNPK(fb[1], b); UNPK(fg[1], g);
#pragma unroll
        for (int q = 0; q < 8; ++q) o[q] = (a[q] + b[q]) * geluf_(g[q]);
        st8(hb + 512 + c8, o);
#pragma unroll
        for (int mx = 0; mx < 2; ++mx) {
            UNPK(fa[2 + mx], a); UNPK(fb[2 + mx], b); UNPK(fg[2 + mx], g);
            float ss = 0.f;
#pragma unroll
            for (int q = 0; q < 8; ++q) { a[q] += b[q]; ss += a[q] * a[q]; }
            ss += shx(ss, 1, lane); ss += shx(ss, 2, lane); ss += shx(ss, 4, lane); ss += shx(ss, 8, lane);
            const float rs = rsqrtf(ss * (1.0f / 128.0f) + EPS);
#pragma unroll
            for (int q = 0; q < 8; ++q) o[q] = a[q] * rs * siluf_(g[q]);
            st8(hb + 1024 + mx * 512 + c8, o);
        }
#undef UNPK
    }
}

__device__ __forceinline__ void phase_final(const Params& P, int bid, int nblk, int wv) {
    const int tid = tid_(wv), lane = tid & 63, wave = __builtin_amdgcn_readfirstlane(tid >> 6);
    const bf16_t* X = WS_PTR(const bf16_t, OFF_X); const bf16_t* YB = WS_PTR(const bf16_t, OFF_YBUF);
    const int* RP0 = WS_PTR(const int, OFF_RP0); const int* RP1 = WS_PTR(const int, OFF_RP1);
    const int step = nblk * 8;
    int row = bid * 8 + wave;
    if (row >= NLAT) return;
    auto clampr = [&](int r) { return r < NLAT ? r : row; };
    f32x4 fg[8];
#pragma unroll
    for (int j = 0; j < 8; ++j) fg[j] = *(const f32x4*)(P.final_g + 4 * lane + 256 * j);
    u32x2 cx[8], ca[8], cb[8];
    { const int q0 = __builtin_amdgcn_readfirstlane(RP0[row]), q1 = __builtin_amdgcn_readfirstlane(RP1[row]);
      const bf16_t* xr = X + (size_t)row * DM + 4 * lane; const bf16_t* y0 = YB + (size_t)q0 * DM + 4 * lane; const bf16_t* y1 = YB + (size_t)q1 * DM + 4 * lane;
#pragma unroll
      for (int j = 0; j < 8; ++j) { cx[j] = *(const u32x2*)(xr + 256 * j); ca[j] = *(const u32x2*)(y0 + 256 * j); cb[j] = *(const u32x2*)(y1 + 256 * j); } }
    int pn0 = RP0[clampr(row + step)], pn1 = RP1[clampr(row + step)];
    for (; row < NLAT; row += step) {
        const int nrow = clampr(row + step), n2 = clampr(row + 2 * step);
        const int q0 = __builtin_amdgcn_readfirstlane(pn0), q1 = __builtin_amdgcn_readfirstlane(pn1);
        pn0 = RP0[n2]; pn1 = RP1[n2];
        const float* g5 = WS_PTR(const float, OFF_MOD) + ((size_t)1 * 17 + mod_row(row)) * 12288 + 5 * 2048;
        f32x4 xv[8];
#pragma unroll
        for (int j = 0; j < 8; ++j) { const f32x4 g = *(const f32x4*)(g5 + 4 * lane + 256 * j);
            xv[j][0] = bflo(cx[j].x) + g[0] * (bflo(ca[j].x) + bflo(cb[j].x)); xv[j][1] = bfhi(cx[j].x) + g[1] * (bfhi(ca[j].x) + bfhi(cb[j].x));
            xv[j][2] = bflo(cx[j].y) + g[2] * (bflo(ca[j].y) + bflo(cb[j].y)); xv[j][3] = bfhi(cx[j].y) + g[3] * (bfhi(ca[j].y) + bfhi(cb[j].y)); }
        { const bf16_t* xr = X + (size_t)nrow * DM + 4 * lane; const bf16_t* y0 = YB + (size_t)q0 * DM + 4 * lane; const bf16_t* y1 = YB + (size_t)q1 * DM + 4 * lane;
#pragma unroll
          for (int j = 0; j < 8; ++j) { cx[j] = *(const u32x2*)(xr + 256 * j); ca[j] = *(const u32x2*)(y0 + 256 * j); cb[j] = *(const u32x2*)(y1 + 256 * j); } }
        const float rstd = row_rstd(xv, lane);
#pragma unroll
        for (int j = 0; j < 8; ++j) *(f32x4*)(P.out + (size_t)row * DM + 4 * lane + 256 * j) = xv[j] * rstd * fg[j];
    }
}
typedef short bf16x8 __attribute__((ext_vector_type(8)));
typedef float f32x16 __attribute__((ext_vector_type(16)));
constexpr int G_RS = 272, G_TS = 144;
constexpr int G_QS = 0, G_KS = G_QS + 64 * G_RS, G_QH = G_KS + 64 * G_RS, G_KT = G_QH + 64 * G_RS, G_VT = G_KT + 128 * G_TS, G_ST = G_VT + 128 * G_TS,
              G_TOT = G_ST + 128 * G_RS, G_EXPL = G_TOT + 8 * 128 * 4, G_END = G_EXPL + 512;
static_assert(G_END <= 147456 - 64, "GLA LDS");
__device__ __forceinline__ bf16x8 ldsfrag(const LAS unsigned char* p) { return *(const LAS bf16x8*)p; }
typedef __bf16 bf16x2_t __attribute__((ext_vector_type(2)));
__device__ __forceinline__ unsigned pkbf(float lo, float hi) { const f32x2 v = {lo, hi}; return __builtin_bit_cast(unsigned, __builtin_convertvector(v, bf16x2_t)); }
__device__ __forceinline__ bf16x8 pack8(float a0, float a1, float a2, float a3, float a4, float a5, float a6, float a7) {
    u32x4 w; w.x = pkbf(a0, a1); w.y = pkbf(a2, a3); w.z = pkbf(a4, a5); w.w = pkbf(a6, a7); return __builtin_bit_cast(bf16x8, w);
}
#define MFMA32(a, b, c) __builtin_amdgcn_mfma_f32_32x32x16_bf16((a), (b), (c), 0, 0, 0)

__device__ __forceinline__ void phase_gla_chunk(const Params& P, int layer, LAS unsigned char* lds, int bid, int nblk, int wv) {
    for (int unit = bid; unit < 256; unit += nblk) {
        const int tid = tid_(wv), lane = tid & 63, w = __builtin_amdgcn_readfirstlane(tid >> 6);
        const int r32 = lane & 31, hh = lane >> 5, th = w >> 2, dq = w & 3;
        const int d0 = 2 * lane;
        const bf16_t* PP = WS_PTR(const bf16_t, OFF_P);
        const int dir = unit & 1, head = (unit >> 1) & 3, b = (unit >> 3) & 15, mx = unit >> 7;
        const int cq = ((mx ? 8 : 3) * 4 + head) * (NTOK * PBLK) + d0, ck = ((mx ? 9 : 4 + dir) * 4 + head) * (NTOK * PBLK) + d0, cv = ((mx ? 10 : 6) * 4 + head) * (NTOK * PBLK) + d0;
        bf16_t* dst = (dir ? WS_PTR(bf16_t, OFF_PB) : WS_PTR(bf16_t, OFF_HB)) + 1024 + mx * 512 + head * 128;
        const f32x2 lb01 = *(const f32x2*)(WS_PTR(const float, OFF_LB) + ((layer * 2 + dir) * 512 + head * 128) + (unsigned)d0);
        const float lb0 = lb01[0], lb1 = lb01[1];
        const float lfret = log1pf(-exp2f(-((dir ? 5.5f : 5.0f) + (float)head)));
        const float qscale = 0.08838834764831845f;
        f32x16 accS[2];
#pragma unroll
        for (int i = 0; i < 16; ++i) { accS[0][i] = 0.f; accS[1][i] = 0.f; }
        __syncthreads();
        unsigned rq[8], rk[8], rv[8];
        const long rstep = dir ? -(long)PBLK : (long)PBLK;
        auto fetch = [&](int c) {
            const bf16_t* pr = PP + (size_t)scan_row(b, dir, 64 * c + 8 * w) * PBLK;
#pragma unroll
            for (int i = 0; i < 8; ++i) { rq[i] = *(const unsigned*)(pr + cq); rk[i] = *(const unsigned*)(pr + ck); rv[i] = *(const unsigned*)(pr + cv); pr += rstep; }
        };
        fetch(0);
        float q0[8], q1[8], k0[8], k1[8], v0[8], v1[8], tot0 = 0.f, tot1 = 0.f;
        auto elem = [&](int c) {
            if (mx == 0) {
                float p0 = 1.0f, p1 = 1.0f;
#pragma unroll
                for (int i = 0; i < 8; ++i) {
                    q0[i] = bflo(rq[i]) * qscale; q1[i] = bfhi(rq[i]) * qscale;
                    const float sg0 = sigmoidf_(bflo(rk[i])), sg1 = sigmoidf_(bfhi(rk[i]));
                    const float f0 = lb0 + (1.0f - lb0) * sg0, f1 = lb1 + (1.0f - lb1) * sg1;
                    k0[i] = (1.0f - lb0) * (1.0f - sg0); k1[i] = (1.0f - lb1) * (1.0f - sg1);
                    p0 *= f0; p1 *= f1;
                    v0[i] = bflo(rv[i]); v1[i] = bfhi(rv[i]);
                }
                tot0 = __logf(p0); tot1 = __logf(p1);
            } else {
                const bool lat = c >= 4;
                if (!lat) {
#pragma unroll
                    for (int i = 0; i < 8; ++i) { q0[i] = bflo(rq[i]); q1[i] = bfhi(rq[i]); k0[i] = bflo(rk[i]) * qscale; k1[i] = bfhi(rk[i]) * qscale;
                        v0[i] = bflo(rv[i]); v1[i] = bfhi(rv[i]); }
                } else {
                    const int m = c - 4;
                    const float rowpos = (float)(dir ? 31 - m : m);
                    int dl = d0; asm volatile("" : "+v"(dl));
                    const bool isrow = (dl & 63) < 32;
                    const float sg = dl < 64 ? -1.0f : 1.0f;
                    const float invf0 = exp2f(-(float)(dl & 31) * (13.287712379549449f / 32.0f)), invf1 = exp2f(-(float)((dl + 1) & 31) * (13.287712379549449f / 32.0f));
                    const float pos0 = isrow ? rowpos : (float)(dir ? 63 - 8 * w : 8 * w);
                    float cc0 = __cosf(pos0 * invf0), ss0 = sg * __sinf(pos0 * invf0), cc1 = __cosf(pos0 * invf1), ss1 = sg * __sinf(pos0 * invf1);
                    const float st = isrow ? 0.0f : (dir ? -1.0f : 1.0f);
                    const float rtc0 = __cosf(st * invf0), rts0 = sg * __sinf(st * invf0), rtc1 = __cosf(st * invf1), rts1 = sg * __sinf(st * invf1);
#pragma unroll
                    for (int i = 0; i < 8; ++i) {
                        const float a0 = bflo(rq[i]), a1 = bfhi(rq[i]), e0 = bflo(rk[i]), e1 = bfhi(rk[i]);
                        const float pa0 = shx(a0, 32, lane), pa1 = shx(a1, 32, lane), pe0 = shx(e0, 32, lane), pe1 = shx(e1, 32, lane);
                        q0[i] = a0 * cc0 + pa0 * ss0; q1[i] = a1 * cc1 + pa1 * ss1;
                        k0[i] = (e0 * cc0 + pe0 * ss0) * qscale; k1[i] = (e1 * cc1 + pe1 * ss1) * qscale;
                        v0[i] = bflo(rv[i]); v1[i] = bfhi(rv[i]);
                        if (i < 7) { const float n0 = cc0 * rtc0 - ss0 * rts0, n1 = cc1 * rtc1 - ss1 * rts1; ss0 = ss0 * rtc0 + cc0 * rts0; ss1 = ss1 * rtc1 + cc1 * rts1; cc0 = n0; cc1 = n1; }
                    }
                }
            }
            if (mx) { tot0 = 8.0f * lfret; tot1 = tot0; }
        };
        elem(0);
        fetch(1);
        for (int c = 0; c < SCAN / 64; ++c) {
            *(LAS f32x2*)(lds + G_TOT + (w * 128 + d0) * 4) = (f32x2){tot0, tot1};
            __syncthreads();
            float pre0 = 0.f, pre1 = 0.f, mid0 = 0.f, mid1 = 0.f, las0 = 0.f, las1 = 0.f;
#pragma unroll
            for (int g = 0; g < 8; ++g) { const f32x2 tt = *(const LAS f32x2*)(lds + G_TOT + (g * 128 + d0) * 4);
                if (g < w) { pre0 += tt[0]; pre1 += tt[1]; } if (g < 4) { mid0 += tt[0]; mid1 += tt[1]; } las0 += tt[0]; las1 += tt[1]; }
            const float em0 = __expf(mid0), em1 = __expf(mid1), el0 = __expf(las0 - mid0), el1 = __expf(las1 - mid1);
            if (w == 0) *(LAS f32x2*)(lds + G_EXPL + d0 * 4) = (f32x2){__expf(las0), __expf(las1)};
            float kh0[8], kh1[8];
            auto a2q = [&](int i, float ea0, float ea1) {
                const float qt0 = q0[i] * ea0, qt1 = q1[i] * ea1; const int t = 8 * w + i;
                *(LAS unsigned*)(lds + G_QS + t * G_RS + d0 * 2) = pkbf(qt0, qt1);
                *(LAS unsigned*)(lds + G_QH + t * G_RS + d0 * 2) = pkbf(qt0 * em0, qt1 * em1);
            };
            auto a2k = [&](int i, float eb0, float eb1) {
                const float kt0 = k0[i] * eb0, kt1 = k1[i] * eb1; const int t = 8 * w + i;
                *(LAS unsigned*)(lds + G_KS + t * G_RS + d0 * 2) = pkbf(kt0, kt1);
                kh0[i] = kt0 * el0; kh1[i] = kt1 * el1;
            };
            if (mx) {
                const float xf = pre0 + lfret - mid0; float rea = __expf(xf), reb = __expf(-xf);
                const float fdec = __expf(lfret), finv = __expf(-lfret);
#pragma unroll
                for (int i = 0; i < 8; ++i) { a2q(i, rea, rea); a2k(i, reb, reb); rea *= fdec; reb *= finv; }
            } else {
                float p0 = __expf(pre0 - mid0), p1 = __expf(pre1 - mid1);
#pragma unroll
                for (int i = 0; i < 8; ++i) { p0 *= 1.0f - k0[i]; p1 *= 1.0f - k1[i]; a2q(i, p0, p1); }
                float s0 = __expf(mid0 - pre0 - tot0), s1 = __expf(mid1 - pre1 - tot1);
#pragma unroll
                for (int i = 7; i >= 0; --i) { a2k(i, s0, s1); s0 *= 1.0f - k0[i]; s1 *= 1.0f - k1[i]; }
            }
            {
                const int p0 = 16 * (w >> 1) + ((w & 1) ? 4 : 0), p1 = 16 * (w >> 1) + ((w & 1) ? 12 : 8);
                *(LAS u32x2*)(lds + G_KT + d0 * G_TS + p0 * 2) = (u32x2){pkbf(kh0[0], kh0[1]), pkbf(kh0[2], kh0[3])};
                *(LAS u32x2*)(lds + G_KT + d0 * G_TS + p1 * 2) = (u32x2){pkbf(kh0[4], kh0[5]), pkbf(kh0[6], kh0[7])};
                *(LAS u32x2*)(lds + G_KT + (d0 + 1) * G_TS + p0 * 2) = (u32x2){pkbf(kh1[0], kh1[1]), pkbf(kh1[2], kh1[3])};
                *(LAS u32x2*)(lds + G_KT + (d0 + 1) * G_TS + p1 * 2) = (u32x2){pkbf(kh1[4], kh1[5]), pkbf(kh1[6], kh1[7])};
                *(LAS u32x2*)(lds + G_VT + d0 * G_TS + p0 * 2) = (u32x2){pkbf(v0[0], v0[1]), pkbf(v0[2], v0[3])};
                *(LAS u32x2*)(lds + G_VT + d0 * G_TS + p1 * 2) = (u32x2){pkbf(v0[4], v0[5]), pkbf(v0[6], v0[7])};
                *(LAS u32x2*)(lds + G_VT + (d0 + 1) * G_TS + p0 * 2) = (u32x2){pkbf(v1[0], v1[1]), pkbf(v1[2], v1[3])};
                *(LAS u32x2*)(lds + G_VT + (d0 + 1) * G_TS + p1 * 2) = (u32x2){pkbf(v1[4], v1[5]), pkbf(v1[6], v1[7])};
            }
#pragma unroll
            for (int kt = 0; kt < 2; ++kt)
#pragma unroll
                for (int g4 = 0; g4 < 4; ++g4)
                    *(LAS u32x2*)(lds + G_ST + (32 * dq + r32) * G_RS + (64 * th + 32 * kt + 8 * g4 + 4 * hh) * 2) = (u32x2){pkbf(accS[kt][4 * g4], accS[kt][4 * g4 + 1]), pkbf(accS[kt][4 * g4 + 2], accS[kt][4 * g4 + 3])};
            __syncthreads();
            const int fo = 16 * hh;
            const bool need_o = !(layer == 1 && c < CTXL / 64);
            f32x16 sc0, sc1;
#pragma unroll
            for (int i = 0; i < 16; ++i) { sc0[i] = 0.f; sc1[i] = 0.f; }
            if (need_o) {
#pragma unroll
            for (int ks = 0; ks < 8; ++ks) {
                const bf16x8 bq = ldsfrag(lds + G_QS + (32 * th + r32) * G_RS + ks * 32 + fo);
                sc0 = MFMA32(ldsfrag(lds + G_KS + r32 * G_RS + ks * 32 + fo), bq, sc0);
                if (th) sc1 = MFMA32(ldsfrag(lds + G_KS + (32 + r32) * G_RS + ks * 32 + fo), bq, sc1);
            }
            }
            if (c + 1 < SCAN / 64) {
                elem(c + 1);
                if (c + 2 < SCAN / 64) fetch(c + 2);
            }
            f32x16 o;
            if (need_o) {
#pragma unroll
            for (int r = 0; r < 16; ++r) { const int s_r = (r & 3) + 8 * (r >> 2) + 4 * hh; const bool keep = s_r <= r32;
                if (th) sc1[r] = keep ? sc1[r] : 0.f; else sc0[r] = keep ? sc0[r] : 0.f; }
#pragma unroll
            for (int i = 0; i < 16; ++i) o[i] = 0.f;
#pragma unroll
            for (int k2 = 0; k2 < 2; ++k2) {
                const bf16x8 pb = pack8(sc0[8 * k2], sc0[8 * k2 + 1], sc0[8 * k2 + 2], sc0[8 * k2 + 3], sc0[8 * k2 + 4], sc0[8 * k2 + 5], sc0[8 * k2 + 6], sc0[8 * k2 + 7]);
                o = MFMA32(ldsfrag(lds + G_VT + (32 * dq + r32) * G_TS + (16 * k2) * 2 + fo), pb, o);
            }
            if (th) {
#pragma unroll
                for (int k2 = 0; k2 < 2; ++k2) {
                    const bf16x8 pb = pack8(sc1[8 * k2], sc1[8 * k2 + 1], sc1[8 * k2 + 2], sc1[8 * k2 + 3], sc1[8 * k2 + 4], sc1[8 * k2 + 5], sc1[8 * k2 + 6], sc1[8 * k2 + 7]);
                    o = MFMA32(ldsfrag(lds + G_VT + (32 * dq + r32) * G_TS + (32 + 16 * k2) * 2 + fo), pb, o);
                }
            }
#pragma unroll
            for (int ks = 0; ks < 8; ++ks)
                o = MFMA32(ldsfrag(lds + G_ST + (32 * dq + r32) * G_RS + ks * 32 + fo), ldsfrag(lds + G_QH + (32 * th + r32) * G_RS + ks * 32 + fo), o);
            }
#pragma unroll
            for (int kt = 0; kt < 2; ++kt) {
#pragma unroll
                for (int g4 = 0; g4 < 4; ++g4) { const f32x4 e4 = *(const LAS f32x4*)(lds + G_EXPL + (64 * th + 32 * kt + 8 * g4 + 4 * hh) * 4);
                    accS[kt][4 * g4] *= e4[0]; accS[kt][4 * g4 + 1] *= e4[1]; accS[kt][4 * g4 + 2] *= e4[2]; accS[kt][4 * g4 + 3] *= e4[3]; }
#pragma unroll
                for (int ks = 0; ks < 4; ++ks)
                    accS[kt] = MFMA32(ldsfrag(lds + G_KT + (64 * th + 32 * kt + r32) * G_TS + ks * 32 + fo), ldsfrag(lds + G_VT + (32 * dq + r32) * G_TS + ks * 32 + fo), accS[kt]);
            }
            if (need_o) {
                bf16_t* orow = dst + (size_t)scan_row(b, dir, 64 * c + 32 * th + r32) * DM + 32 * dq + 4 * hh;
#pragma unroll
                for (int g4 = 0; g4 < 4; ++g4) *(u32x2*)(orow + 8 * g4) = (u32x2){pkbf(o[4 * g4], o[4 * g4 + 1]), pkbf(o[4 * g4 + 2], o[4 * g4 + 3])};
            }
        }
    }
    __syncthreads();
}
typedef float f32x4_ __attribute__((ext_vector_type(4)));
#define MFMA16(a, b, c) __builtin_amdgcn_mfma_f32_16x16x32_bf16((a), (b), (c), 0, 0, 0)
__device__ __forceinline__ float swap32(float x, int hh) {
    const auto r = __builtin_amdgcn_permlane32_swap(__float_as_uint(x), __float_as_uint(x), false, false);
    return __uint_as_float(hh ? r[0] : r[1]);
}
constexpr int S5_LDS = 32 * 272;
constexpr int LRU_LDS = 32 * 144;

__device__ __forceinline__ void s5_unit(const Params& P, int layer, int b, int g, int dir, LAS unsigned char* hl, int lane) {
    const int r32 = lane & 31, hh = lane >> 5;
    const int pi = (layer * 2 + dir) * 32 + g;
    const bf16_t* PP = WS_PTR(const bf16_t, OFF_P);
    bf16_t* dst = (dir ? WS_PTR(bf16_t, OFF_PB) : WS_PTR(bf16_t, OFF_HB)) + g * 16 + 4 * (lane >> 4);
    const float dt = expf(P.s5_log_dt[pi]);
    float akr[2][4], aki[2][4];
    bf16x8 Bp[4];
#pragma unroll
    for (int s = 0; s < 2; ++s) {
        const int p = r32 + 32 * s;
        const float lr = P.s5_lam_re[pi * 64 + p], li = P.s5_lam_im[pi * 64 + p];
        const float mag = expf(lr * dt), ar = mag * cosf(li * dt), ai = mag * sinf(li * dt);
        const float den = lr * lr + li * li, zr = ar - 1.0f;
        const float wre = (zr * lr + ai * li) / den, wim = (ai * lr - zr * li) / den;
        akr[s][0] = ar; aki[s][0] = ai;
#pragma unroll
        for (int k = 1; k < 4; ++k) { akr[s][k] = akr[s][k - 1] * ar - aki[s][k - 1] * ai; aki[s][k] = akr[s][k - 1] * ai + aki[s][k - 1] * ar; }
        float vr[8], vi[8];
#pragma unroll
        for (int jj = 0; jj < 8; ++jj) { const int c = 8 * hh + jj; const float br = P.s5_b_re[((size_t)pi * 16 + c) * 64 + p], bi = P.s5_b_im[((size_t)pi * 16 + c) * 64 + p];
            vr[jj] = wre * br - wim * bi; vi[jj] = wre * bi + wim * br; }
        Bp[s] = pack8(vr[0], vr[1], vr[2], vr[3], vr[4], vr[5], vr[6], vr[7]);
        Bp[2 + s] = pack8(vi[0], vi[1], vi[2], vi[3], vi[4], vi[5], vi[6], vi[7]);
    }
    bf16x8 Cm[4];
#pragma unroll
    for (int ks = 0; ks < 4; ++ks) { float cv[8];
#pragma unroll
        for (int jj = 0; jj < 8; ++jj) { const int kp = 32 * ks + 8 * (lane >> 4) + jj, plo = kp >> 2, nt = kp & 3, p = plo + 32 * (nt & 1);
            cv[jj] = (nt >> 1) ? -P.s5_c_im[((size_t)pi * 64 + p) * 16 + (lane & 15)] : P.s5_c_re[((size_t)pi * 64 + p) * 16 + (lane & 15)]; }
        Cm[ks] = pack8(cv[0], cv[1], cv[2], cv[3], cv[4], cv[5], cv[6], cv[7]); }
    float cr[2] = {0.f, 0.f}, ci[2] = {0.f, 0.f};
    bf16x8 ua = *(const bf16x8*)(PP + p_off(scan_row(b, dir, r32), g * 16 + 8 * hh));
    for (int tile = 0; tile < SCAN / 32; ++tile) {
        const int tn = tile + 1 < SCAN / 32 ? tile + 1 : tile;
        const bf16x8 un = *(const bf16x8*)(PP + p_off(scan_row(b, dir, 32 * tn + r32), g * 16 + 8 * hh));
        f32x16 D[4];
#pragma unroll
        for (int nt = 0; nt < 4; ++nt) { f32x16 z;
#pragma unroll
            for (int i = 0; i < 16; ++i) z[i] = 0.f;
            D[nt] = MFMA32(ua, Bp[nt], z); }
#pragma unroll
        for (int i = 0; i < 4; ++i) {
#pragma unroll
            for (int s = 0; s < 2; ++s) {
                const float ar = akr[s][0], ai = aki[s][0];
                float xr[4], xi[4];
                xr[0] = D[s][4 * i]; xi[0] = D[2 + s][4 * i];
#pragma unroll
                for (int k = 1; k < 4; ++k) { xr[k] = ar * xr[k - 1] - ai * xi[k - 1] + D[s][4 * i + k]; xi[k] = ar * xi[k - 1] + ai * xr[k - 1] + D[2 + s][4 * i + k]; }
                const float pxr = swap32(xr[3], hh), pxi = swap32(xi[3], hh);
                const float cer = hh ? (akr[s][3] * cr[s] - aki[s][3] * ci[s] + pxr) : cr[s];
                const float cei = hh ? (akr[s][3] * ci[s] + aki[s][3] * cr[s] + pxi) : ci[s];
#pragma unroll
                for (int k = 0; k < 4; ++k) { const float hr = xr[k] + akr[s][k] * cer - aki[s][k] * cei, hi = xi[k] + akr[s][k] * cei + aki[s][k] * cer; D[s][4 * i + k] = hr; D[2 + s][4 * i + k] = hi; }
                const float phr = swap32(D[s][4 * i + 3], hh), phi = swap32(D[2 + s][4 * i + 3], hh);
                cr[s] = hh ? D[s][4 * i + 3] : phr; ci[s] = hh ? D[2 + s][4 * i + 3] : phi;
            }
        }
#pragma unroll
        for (int r = 0; r < 16; ++r) { const int t = (r & 3) + 8 * (r >> 2) + 4 * hh;
            *(LAS u32x2*)(hl + t * 272 + 8 * r32) = (u32x2){pkbf(D[0][r], D[1][r]), pkbf(D[2][r], D[3][r])}; }
        f32x4_ y[2];
#pragma unroll
        for (int mt = 0; mt < 2; ++mt) { y[mt] = (f32x4_){0.f, 0.f, 0.f, 0.f};
#pragma unroll
            for (int ks = 0; ks < 4; ++ks) y[mt] = MFMA16(Cm[ks], *(const LAS bf16x8*)(hl + (16 * mt + (lane & 15)) * 272 + (32 * ks + 8 * (lane >> 4)) * 2), y[mt]); }
#pragma unroll
        for (int mt = 0; mt < 2; ++mt) *(u32x2*)(dst + (size_t)scan_row(b, dir, 32 * tile + 16 * mt + (lane & 15)) * DM) = (u32x2){pkbf(y[mt][0], y[mt][1]), pkbf(y[mt][2], y[mt][3])};
        ua = un;
    }
}

__device__ __forceinline__ void lru_unit(const Params& P, int layer, int b, int dir, int head, int nh, LAS unsigned char* xl, int lane) {
    const int r32 = lane & 31, hh = lane >> 5;
    const int li = layer * 2 + dir;
    const bf16_t* PPu = WS_PTR(const bf16_t, OFF_P) + (size_t)(4 + (head >> 1)) * NTOK * PBLK + (head & 1) * 64;
    bf16_t* dstu = (dir ? WS_PTR(bf16_t, OFF_PB) : WS_PTR(bf16_t, OFF_HB)) + 512 + head * 64 + 32 * nh;
    const int sto = r32 + ((dir ? !hh : hh) ? 4 * DM : 0);
    float cw[4];
#pragma unroll
    for (int k = 0; k < 4; ++k) cw[k] = P.lru_conv_w[(layer * 4 + k) * 512 + head * 64 + lane];
    const float cb = P.lru_conv_b[layer * 512 + head * 64 + lane];
    bf16x8 Ba[4], Bx[4];
#pragma unroll
    for (int ks = 0; ks < 4; ++ks) { float va[8], vx[8];
#pragma unroll
        for (int jj = 0; jj < 8; ++jj) { const int i = 16 * ks + 8 * hh + jj; const size_t o = (((size_t)li * 8 + head) * 64 + i) * 64 + 32 * nh + r32; va[jj] = P.lru_wa[o]; vx[jj] = P.lru_wx[o]; }
        Ba[ks] = pack8(va[0], va[1], va[2], va[3], va[4], va[5], va[6], va[7]); Bx[ks] = pack8(vx[0], vx[1], vx[2], vx[3], vx[4], vx[5], vx[6], vx[7]); }
    const int chj = head * 64 + 32 * nh + r32;
    const float ba = P.lru_ba[li * 512 + chj], bx = P.lru_bx[li * 512 + chj];
    const float spl8 = -8.0f * log1pf(expf(-P.lru_lam[li * 512 + chj]));
    float cin = 0.f;
    unsigned short rawA[35], rawB[35];
    auto load_raw = [&](int tile, unsigned short (&r16)[35]) {
        int base, len, tt;
        if (tile < CTXL / 32) { base = NLAT + b * CTXL; len = CTXL; tt = tile; } else { base = b * SEQ; len = SEQ; tt = tile - CTXL / 32; }
        const int nmin = dir ? len - 32 - 32 * tt : 32 * tt;
        if (nmin >= 2 && nmin + 33 <= len) {
            const bf16_t* p = PPu + (size_t)(base + nmin - 2) * PBLK + lane;
#pragma unroll
            for (int wq = 0; wq < 35; ++wq) { r16[wq] = *p; p += PBLK; asm volatile("" : "+v"(p)); }
        } else {
#pragma unroll
            for (int wq = 0; wq < 35; ++wq) { int np = nmin - 2 + wq; np = np < 0 ? 0 : (np >= len ? len - 1 : np); r16[wq] = (PPu + (size_t)(base + np) * PBLK)[lane]; }
        }
    };
    auto do_tile = [&](int tile, unsigned short (&r16)[35]) {
        int base, len, tt;
        if (tile < CTXL / 32) { base = NLAT + b * CTXL; len = CTXL; tt = tile; } else { base = b * SEQ; len = SEQ; tt = tile - CTXL / 32; }
        const int nmin = dir ? len - 32 - 32 * tt : 32 * tt;
        float raw[35];
        if (nmin >= 2 && nmin + 33 <= len) {
#pragma unroll
            for (int wq = 0; wq < 35; ++wq) raw[wq] = bf2f(r16[wq]);
        } else {
#pragma unroll
            for (int wq = 0; wq < 35; ++wq) { const int np = nmin - 2 + wq; raw[wq] = (np >= 0 && np < len) ? bf2f(r16[wq]) : 0.f; }
        }
#pragma unroll
        for (int m = 0; m < 32; ++m) { const float xc = cb + cw[0] * raw[m] + cw[1] * raw[m + 1] + cw[2] * raw[m + 2] + cw[3] * raw[m + 3];
            const int q = dir ? 31 - m : m; *(LAS bf16_t*)(xl + q * 144 + lane * 2) = (bf16_t)pkbf(xc, xc); }
        if (tile + 2 < SCAN / 32) load_raw(tile + 2, r16);
        f32x16 accA, accX;
#pragma unroll
        for (int i = 0; i < 16; ++i) { accA[i] = 0.f; accX[i] = 0.f; }
#pragma unroll
        for (int ks = 0; ks < 4; ++ks) { const bf16x8 af = *(const LAS bf16x8*)(xl + r32 * 144 + (16 * ks + 8 * hh) * 2); accA = MFMA32(af, Ba[ks], accA); accX = MFMA32(af, Bx[ks], accX); }
#pragma unroll
        for (int i = 0; i < 4; ++i) {
            float x[4], A[4];
#pragma unroll
            for (int k = 0; k < 4; ++k) { const int r = 4 * i + k, q = k + 8 * i + 4 * hh;
                const float xc = bf2f(*(const LAS bf16_t*)(xl + q * 144 + (32 * nh + r32) * 2));
                const float rg = sigmoidf_(accA[r] + ba), ig = sigmoidf_(accX[r] + bx);
                const float a = __expf(spl8 * rg);
                const float bb = __builtin_amdgcn_sqrtf(fmaxf(1.0f - a * a, 0.f)) * (ig * xc);
                if (k == 0) { x[0] = bb; A[0] = a; } else { x[k] = a * x[k - 1] + bb; A[k] = a * A[k - 1]; } }
            const float px3 = swap32(x[3], hh), pA3 = swap32(A[3], hh);
            const float ce = hh ? (pA3 * cin + px3) : cin;
            float h[4];
#pragma unroll
            for (int k = 0; k < 4; ++k) h[k] = x[k] + A[k] * ce;
            const float ph3 = swap32(h[3], hh);
            cin = hh ? h[3] : ph3;
#pragma unroll
            for (int k = 0; k < 4; ++k) { const int q0 = k + 8 * i, npu = dir ? nmin + 31 - q0 - 4 : nmin + q0; (dstu + (size_t)(base + npu) * DM)[sto] = (bf16_t)pkbf(h[k], h[k]); }
        }
    };
    load_raw(0, rawA); load_raw(1, rawB);
    for (int tile = 0; tile < SCAN / 32; tile += 2) { do_tile(tile, rawA); do_tile(tile + 1, rawB); }
}

constexpr int MIX_CQ = 4 * S5_LDS + 2 * LRU_LDS + 4 * 8448;
__device__ __forceinline__ void phase_s5_lru(const Params& P, int layer, LAS unsigned char* lds, int bid, int nblk, int wv) {
    const int tid = tid_(wv), lane = tid & 63, w = __builtin_amdgcn_readfirstlane(tid >> 6);
    LAS int* cq = (LAS int*)(lds + MIX_CQ);
    __syncthreads();
    if (tid == 0) *cq = 0;
    __syncthreads();
    LAS float* scr;
    if (w < 2) {
        for (int j = bid; j < NB * 2 * 8; j += nblk) lru_unit(P, layer, j >> 4, j & 1, (j >> 1) & 7, w, lds + 4 * S5_LDS + w * LRU_LDS, lane);
        scr = (LAS float*)(lds + 4 * S5_LDS + 2 * LRU_LDS + (2 + w) * 8448);
    } else if (w == 4 || w == 5) {
        scr = (LAS float*)(lds + 4 * S5_LDS + 2 * LRU_LDS + (w - 4) * 8448);
    } else {
        const int sw = (w & 1) + ((w >> 2) << 1);
        for (int j = bid; j < NB * 8 * 2; j += nblk) s5_unit(P, layer, j >> 4, 4 * ((j >> 1) & 7) + sw, j & 1, lds + sw * S5_LDS, lane);
        scr = (LAS float*)(lds + sw * S5_LDS);
    }
    convert_moe_queue(P, layer, scr, cq, bid, nblk, lane);
    __syncthreads();
}
__device__ __forceinline__ void phase_gemm_in(const Params& P, int layer, LAS unsigned char* lds, int bid, int nblk, int wv) {
    pg8::Gemm g{WS_PTR(const bf16_t, OFF_HB), WS_PTR(const bf16_t, OFF_WIN) + (size_t)layer * NPC * DM, NTOK, NPC, DM};
    pg8::EpiPlainBf16 E{WS_PTR(bf16_t, OFF_P), 0  , 6 * 512 / 256, 7 * 512 / 256};
    if (layer == 0) { pg8::StaticOrder S; S.init(NTOK, NPC, nblk, bid); pg8::gemm_phase<pg8::EpiPlainBf16, pg8::StaticOrder, true, true>(lds, g, S, E, wv); }
    else { pg8::InOrderLast S; S.init(nblk, bid); pg8::gemm_phase<pg8::EpiPlainBf16, pg8::InOrderLast, true, true>(lds, g, S, E, wv); }
}
__device__ __forceinline__ void phase_gemm_glu(const Params& P, int layer, int nrows, LAS unsigned char* lds, int bid, int nblk, int wv) {
    pg8::Gemm g{WS_PTR(const bf16_t, OFF_GY), WS_PTR(const bf16_t, OFF_WGLU) + (size_t)layer * 512 * 512, nrows, 512, 512};
    pg8::StaticOrder S; S.init(nrows, 512, nblk, bid);
    pg8::EpiGlu E{WS_PTR(bf16_t, OFF_HB), DM, WS_PTR(const bf16_t, OFF_GY), P.s5_glu_b + layer * 512};
    pg8::gemm_phase<pg8::EpiGlu, pg8::StaticOrder, true, true>(lds, g, S, E, wv);
}
__device__ __forceinline__ void phase_gemm_out(const Params& P, int layer, int nrows, LAS unsigned char* lds, int bid, int nblk, int wv) {
    pg8::Gemm g{WS_PTR(const bf16_t, OFF_HB), WS_PTR(const bf16_t, OFF_WOUT) + (size_t)layer * DM * DM, nrows, DM, DM};
    pg8::StaticOrder S; S.init(nrows, DM, nblk, bid);
    pg8::EpiResid E{WS_PTR(bf16_t, OFF_X), WS_PTR(const float, OFF_MOD) + (size_t)layer * 17 * 12288 + 2 * 2048, layer == 0 ? P.x : nullptr, layer == 0 ? P.ctx : nullptr};
    pg8::gemm_phase<pg8::EpiResid, pg8::StaticOrder, true, true>(lds, g, S, E, wv);
}
__device__ __forceinline__ void phase_gemm_moe1(const Params& P, LAS unsigned char* lds, int bid, int nblk, int wv) {
    pg8::Gemm g{WS_PTR(const bf16_t, OFF_HB), WS_PTR(const bf16_t, OFF_W1), MPAD, 2048, DM};
    pg8::MoeOrder S{WS_PTR(const int, OFF_TILE), WS_PTR(const int, OFF_TILE)[511], nblk, bid};
    LAS unsigned* gtab = (LAS unsigned*)(lds + 131072);
    { const int tid = tid_(wv); const int* ST = WS_PTR(const int, OFF_SORTTOK);
      __syncthreads();
      for (int i = 0; i < 12; ++i) { pg8::Unit u; if (!S.next(i, u)) break;
          if (tid < 256) { const int tok = ST[u.pm * 256 + tid]; gtab[i * 256 + tid] = (unsigned)(tok < 0 ? 0 : tok) * (unsigned)(DM * 2); } }
      __syncthreads(); }
    pg8::EpiSwiGlu E{WS_PTR(bf16_t, OFF_HE)};
    pg8::gemm_phase<pg8::EpiSwiGlu, pg8::MoeOrder, true, true, true>(lds, g, S, E, wv, gtab);
}
__device__ __forceinline__ void phase_gemm_moe2(const Params& P, LAS unsigned char* lds, int bid, int nblk, int wv) {
    pg8::Gemm g{WS_PTR(const bf16_t, OFF_HE), WS_PTR(const bf16_t, OFF_W2), MPAD, 2048, DFF};
    pg8::MoeOrder S{WS_PTR(const int, OFF_TILE), WS_PTR(const int, OFF_TILE)[511], nblk, bid};
    pg8::EpiScaleRow E{WS_PTR(bf16_t, OFF_YBUF), WS_PTR(const float, OFF_SORTGATE)};
    pg8::gemm_phase<pg8::EpiScaleRow, pg8::MoeOrder, true, true>(lds, g, S, E, wv);
}

constexpr int LDS_BYTES = 147456;
constexpr int LDS_BARW = LDS_BYTES - 64;
__device__ __forceinline__ Params load_params() {
    typedef const unsigned long long __attribute__((address_space(4)))* KA;
    typedef const float __attribute__((address_space(1)))* GCF;
    KA ka = (KA)__builtin_amdgcn_kernarg_segment_ptr();
    asm volatile("" : "+s"(ka));
    Params P; const float** d = (const float**)&P;
#pragma unroll
    for (int i = 0; i < 34; ++i) d[i] = (const float*)(GCF)ka[i];
    P.out = (float*)(float __attribute__((address_space(1)))*)ka[34];
    P.ws = (unsigned char*)(unsigned char __attribute__((address_space(1)))*)ka[35];
    return P;
}
#define PH(call) do { const Params P = load_params(); call; } while (0)
__global__ void __launch_bounds__(512, 2) k_forward(Params P_arg_unused) {
    extern __shared__ __attribute__((aligned(16))) unsigned char lds_raw[];
    LAS unsigned char* lds = (LAS unsigned char*)lds_raw;
    const int bid = blockIdx.x, nblk = gridDim.x;
    const int wv = __builtin_amdgcn_readfirstlane(threadIdx.x >> 6);
    if (threadIdx.x < 16) ((LAS unsigned*)(lds + LDS_BARW))[threadIdx.x] = 0u;
    __syncthreads();
    (void)xcd_barrier_post((unsigned*)(load_params().ws + OFF_CTL), (volatile LAS unsigned*)(lds + LDS_BARW));
#define GRID_BAR() do { XcdBarrier b_; b_.bar = (unsigned*)(load_params().ws + OFF_CTL); b_.x = xb_xcc_id(); b_.st = (volatile LAS unsigned*)(lds + LDS_BARW); xcd_barrier(b_); } while (0)
    PH(phase_mod(P, 0, 2, lds, bid, nblk, wv));
    { const int skip = nblk > 96 ? 96 : 0;
      if (bid >= skip) PH(phase_convert_small(P, 0, 2, lds, bid - skip, nblk - skip, wv)); }
    GRID_BAR();
    for (int layer = 0; layer < 2; ++layer) {
        const int nrows = layer == 0 ? NTOK : NLAT;
        PH(phase_norm1(P, layer, bid, nblk, wv));
        GRID_BAR();
        PH(phase_gemm_in(P, layer, lds, bid, nblk, wv));
        GRID_BAR();
        PH(phase_s5_lru(P, layer, lds, bid, nblk, wv));
        PH(phase_gla_chunk(P, layer, lds, bid, nblk, wv));
        GRID_BAR();
        PH(phase_finalize_s5(P, layer, nrows, bid, nblk, wv));
        GRID_BAR();
        { const int NGLU = nblk >= 192 ? 96 : 0;
          if (NGLU == 0) { PH(phase_finalize_rest(P, layer, nrows, bid, nblk, wv)); GRID_BAR(); PH(phase_gemm_glu(P, layer, nrows, lds, bid, nblk, wv)); }
          else if (bid < NGLU) PH(phase_gemm_glu(P, layer, nrows, lds, bid, NGLU, wv));
          else PH(phase_finalize_rest(P, layer, nrows, bid - NGLU, nblk - NGLU, wv)); }
        GRID_BAR();
        PH(phase_gemm_out(P, layer, nrows, lds, bid, nblk, wv));
        GRID_BAR();
        PH(phase_norm2(P, layer, 256, nrows / 256, lds, bid, nblk, wv));
        GRID_BAR();
        PH(phase_route2(P, 256, nrows / 256, lds, bid, nblk, wv));
        GRID_BAR();
        PH(phase_gemm_moe1(P, lds, bid, nblk, wv));
        GRID_BAR();
        PH(phase_gemm_moe2(P, lds, bid, nblk, wv));
        GRID_BAR();
    }
    PH(phase_final(P, bid, nblk, wv));
}

extern "C" void kernel_launch(void* const* d_in, const int* in_sizes, int n_in, void* d_out, int out_size, void* d_ws, size_t ws_size, hipStream_t stream) {
    static int grid = 0;
    if (grid == 0) {
        if (n_in != 34 || ws_size < WS_END) { fprintf(stderr, "kernel_launch: n_in %d ws %zu (need %zu)\n", n_in, ws_size, (size_t)WS_END); grid = -1; return; }
        int dev = 0, cus = 0, per_cu = 0;
        if (hipGetDevice(&dev) != hipSuccess || hipDeviceGetAttribute(&cus, hipDeviceAttributeMultiprocessorCount, dev) != hipSuccess) { grid = -1; return; }
        if (hipFuncSetAttribute((const void*)k_forward, hipFuncAttributeMaxDynamicSharedMemorySize, LDS_BYTES) != hipSuccess) { fprintf(stderr, "kernel_launch: hipFuncSetAttribute failed\n"); grid = -1; return; }
        if (hipOccupancyMaxActiveBlocksPerMultiprocessor(&per_cu, (const void*)k_forward, 512, LDS_BYTES) != hipSuccess || per_cu < 1) { fprintf(stderr, "kernel_launch: occupancy query says %d\n", per_cu); (void)hipGetLastError(); per_cu = 1; }
        grid = cus;
    }
    if (grid < 0) return;
    if (hipMemsetAsync((char*)d_ws + OFF_CTL, 0, CTL_BYTES, stream) != hipSuccess) return;
    Params P{};
    const float** pp = (const float**)&P;
    for (int i = 0; i < 34; ++i) pp[i] = (const float*)d_in[i];
    P.out = (float*)d_out; P.ws = (unsigned char*)d_ws;
    hipLaunchKernelGGL(k_forward, dim3(grid), dim3(512), LDS_BYTES, stream, P);
}
```

```cpp
#include <hip/hip_runtime.h>
#include <cstdio>
#include <cstdint>
__device__ __forceinline__ int tid_(int wv) { int l; asm volatile("v_mbcnt_lo_u32_b32 %0, -1, 0\n\tv_mbcnt_hi_u32_b32 %0, -1, %0" : "=v"(l)); return (wv << 6) | l; }
namespace pg8 {
#define PG8_LAS __attribute__((address_space(3)))
typedef unsigned short bf16_t;
typedef short bf16x8 __attribute__((ext_vector_type(8)));
typedef float f32x4 __attribute__((ext_vector_type(4)));
typedef unsigned u32x4 __attribute__((ext_vector_type(4)));
constexpr int BM = 256, BK = 64, HALF = 128, HTB = HALF * BK * 2  , STAGE_BYTES = 8 * HTB, NXCD = 8, WGM = 8;

__host__ __device__ __forceinline__ int lds_byte(int r, int c) { const int st = (r >> 4) * 2 + (c >> 5), rr = r & 15, cc = c & 31, ob = rr * 64 + cc * 2; return st * 1024 + (ob ^ (((ob >> 9) & 1) << 5)); }
__host__ __device__ __forceinline__ void stage_rc(int b, int& R, int& C) { const int st = b / 1024, sb = b % 1024, swz = sb ^ (((sb >> 9) & 1) << 5); R = (st >> 1) * 16 + swz / 64; C = (st & 1) * 32 + (swz % 64) / 2; }
__host__ __device__ __forceinline__ int perm32(int rho) { const int n = rho >> 4, i = rho & 15; return 8 * (i >> 2) + 4 * n + (i & 3); }

struct Unit { int pm, pn; };
struct Gemm { const bf16_t* A; const bf16_t* Bt; int M, N, K; };

struct StaticOrder {
    int nM, nN, nwg, G, c;
    __host__ __device__ void init(int M, int N, int G_, int c_) { nM = M / BM; nN = N / BM; nwg = nM * nN; G = G_; c = c_; }
    __host__ __device__ bool next(int i, Unit& u) const {
        const long L = (long)i * G + c; if (L >= nwg) return false;
        int wgid = (int)L; { const int q = nwg / NXCD, r = nwg % NXCD, xcd = wgid % NXCD, off = wgid / NXCD; wgid = (xcd < r ? xcd * (q + 1) : r * (q + 1) + (xcd - r) * q) + off; }
        const int nig = WGM * nN, gid = wgid / nig, fm = gid * WGM, gsz = (nM - fm) < WGM ? (nM - fm) : WGM;
        u.pm = fm + ((wgid % nig) % gsz); u.pn = (wgid % nig) / gsz; return true;
    }
    __device__ __forceinline__ void a_ready(const Unit&) const {}
    __device__ __forceinline__ void done(const Unit&) const {}
};
typedef __bf16 bf16x2_t_ __attribute__((ext_vector_type(2))); typedef float f32x2_ __attribute__((ext_vector_type(2)));
__device__ __forceinline__ unsigned cvt_pk_bf16(float lo, float hi) { const f32x2_ v = {lo, hi}; return __builtin_bit_cast(unsigned, __builtin_convertvector(v, bf16x2_t_)); }
template <class Epi, class Sched, bool ALIGN_EPI = false, bool SP2 = false, bool GATHER = false>
__device__ __forceinline__ void gemm_phase(PG8_LAS unsigned char* lds, const Gemm g, const Sched& S, const Epi& E, int wv, const PG8_LAS unsigned* gtab = nullptr) {
    const int tid = tid_(wv), wid = __builtin_amdgcn_readfirstlane(tid >> 6), lane = tid & 63, wr = wid >> 2, wc = wid & 3, fr = lane & 15, fq = lane >> 4;
    const int K = g.K, nt = K / BK;
    unsigned voffA[2], voffB[2];
#pragma unroll
    for (int i = 0; i < 2; ++i) { int R, C; stage_rc(tid * 16 + i * 8192, R, C); const int Rb = Epi::PERM ? ((R & ~31) + perm32(R & 31)) : R;
        voffA[i] = (unsigned)(R * K + C) * 2u; voffB[i] = (unsigned)(Rb * K + C) * 2u; }
    int gR[2]; unsigned gC[2];
#pragma unroll
    for (int i = 0; i < 2; ++i) { int R, C; stage_rc(tid * 16 + i * 8192, R, C); gR[i] = R; gC[i] = (unsigned)C * 2u; }
    unsigned vgC[2][2], vgN[2][2];
#define PG8_GOFFS(dst, uidx) do { _Pragma("unroll") for (int _h = 0; _h < 2; ++_h) _Pragma("unroll") for (int _i = 0; _i < 2; ++_i) dst[_h][_i] = gtab[(uidx) * 256 + 128 * _h + gR[_i]] + gC[_i]; } while (0)
#define PG8_STAGE_A(bufoff, gbase, h, nx) do { if constexpr (GATHER) { _Pragma("unroll") for (int _i = 0; _i < 2; ++_i) { const unsigned _o = (nx) ? vgN[h][_i] : vgC[h][_i]; \
        __builtin_amdgcn_global_load_lds((const unsigned*)((const char*)(gbase) + _o), (PG8_LAS unsigned*)(lds + (bufoff) + ldsw + _i * 8192), 16, 0, 0); } } \
        else { PG8_STAGE(bufoff, (gbase) + (h) * hstep, voffA); } } while (0)
    const size_t kstep = (size_t)(BK * 2);
    const size_t hstep = (size_t)HALF * K * 2;
    const size_t tstep = 2 * hstep;
    const unsigned ldsw = (unsigned)wid * 1024u;
    const int aoff = lds_byte(wr * 64 + fr, fq * 8), boff = lds_byte(wc * 32 + fr, fq * 8);
#define PG8_SA(b, h) (((b) * 2 + (h)) * HTB)
#define PG8_SB(b, h) ((4 + (b) * 2 + (h)) * HTB)
#define PG8_STAGE(bufoff, gbase, voff) do { _Pragma("unroll") for (int _i = 0; _i < 2; ++_i) \
        __builtin_amdgcn_global_load_lds((const unsigned*)((const char*)(gbase) + (voff)[_i]), (PG8_LAS unsigned*)(lds + (bufoff) + ldsw + _i * 8192), 16, 0, 0); } while (0)
#define PG8_LDA(dst, b, h) do { _Pragma("unroll") for (int m = 0; m < 4; ++m) _Pragma("unroll") for (int k = 0; k < 2; ++k) dst[m][k] = *(const PG8_LAS bf16x8*)(lds + PG8_SA(b, h) + aoff + m * 2048 + k * 1024); } while (0)
#define PG8_LDB(dst, b, h) do { _Pragma("unroll") for (int n = 0; n < 2; ++n) _Pragma("unroll") for (int k = 0; k < 2; ++k) dst[n][k] = *(const PG8_LAS bf16x8*)(lds + PG8_SB(b, h) + boff + n * 2048 + k * 1024); } while (0)
#define PG8_MMA(ai, bj, At, Bt) do { __builtin_amdgcn_s_setprio(1); _Pragma("unroll") for (int m = 0; m < 4; ++m) _Pragma("unroll") for (int n = 0; n < 2; ++n) _Pragma("unroll") for (int k = 0; k < 2; ++k) \
        acc[ai][bj][m][n] = __builtin_amdgcn_mfma_f32_16x16x32_bf16(Bt[n][k], At[m][k], acc[ai][bj][m][n], 0, 0, 0); __builtin_amdgcn_s_setprio(0); } while (0)
#define PG8_WAIT_V(n) asm volatile("s_waitcnt vmcnt(" #n ")" ::: "memory")
#define PG8_WAIT_L(n) asm volatile("s_waitcnt lgkmcnt(" #n ")" ::: "memory")
#define PG8_BAR __builtin_amdgcn_s_barrier()
#define PG8_SCHED __builtin_amdgcn_sched_barrier(0)
    Unit cur, nxt; int ui = 0;
    if (!S.next(0, cur)) return;
    f32x4 acc[2][2][4][2];
#pragma unroll
    for (int a = 0; a < 2; ++a)
#pragma unroll
        for (int b = 0; b < 2; ++b)
#pragma unroll
            for (int m = 0; m < 4; ++m)
#pragma unroll
                for (int n = 0; n < 2; ++n) acc[a][b][m][n] = (f32x4){0.f, 0.f, 0.f, 0.f};
    bf16x8 At[4][2], B0[2][2], B1[2][2];
    const char* cA = (const char*)g.A + (GATHER ? (size_t)0 : (size_t)cur.pm * tstep); const char* cB = (const char*)g.Bt + (size_t)cur.pn * tstep;
    if constexpr (GATHER) PG8_GOFFS(vgC, 0);
    S.a_ready(cur);
    if constexpr (SP2) {
        PG8_STAGE(PG8_SB(0, 0), cB, voffB); PG8_STAGE(PG8_SB(0, 1), cB + hstep, voffB); PG8_STAGE_A(PG8_SA(0, 0), cA, 0, false); PG8_STAGE_A(PG8_SA(0, 1), cA, 1, false);
        if (wr == 1) PG8_BAR;
        PG8_WAIT_V(2); PG8_BAR;
        PG8_STAGE(PG8_SB(1, 0), cB + kstep, voffB); PG8_STAGE_A(PG8_SA(1, 0), cA + kstep, 0, false); PG8_STAGE(PG8_SB(1, 1), cB + hstep + kstep, voffB);
        PG8_WAIT_V(6); PG8_BAR;
    } else {
        PG8_STAGE(PG8_SB(0, 0), cB, voffB); PG8_STAGE_A(PG8_SA(0, 0), cA, 0, false); PG8_STAGE(PG8_SB(0, 1), cB + hstep, voffB); PG8_STAGE_A(PG8_SA(0, 1), cA, 1, false);
        if (wr == 1) PG8_BAR;
        PG8_WAIT_V(4); PG8_BAR;
        PG8_STAGE(PG8_SB(1, 0), cB + kstep, voffB); PG8_STAGE_A(PG8_SA(1, 0), cA + kstep, 0, false); PG8_STAGE(PG8_SB(1, 1), cB + hstep + kstep, voffB);
        PG8_WAIT_V(6); PG8_BAR;
    }
    for (;;) {
        const bool has_next = S.next(ui + 1, nxt);
        if constexpr (GATHER) { if (has_next) PG8_GOFFS(vgN, ui + 1); else { _Pragma("unroll") for (int _h = 0; _h < 2; ++_h) _Pragma("unroll") for (int _i = 0; _i < 2; ++_i) vgN[_h][_i] = vgC[_h][_i]; } }
        const char* nA = (has_next && !GATHER) ? (const char*)g.A + (size_t)nxt.pm * tstep : cA; const char* nB = has_next ? (const char*)g.Bt + (size_t)nxt.pn * tstep : cB;
        for (int t = 0; t < nt; t += 2) {
            const bool last = (t == nt - 2);
            const char* a1 = cA + (size_t)(t + 1) * kstep;
            const char* a2 = last ? nA : cA + (size_t)(t + 2) * kstep; const char* b2 = last ? nB : cB + (size_t)(t + 2) * kstep;
            const char* a3 = a2 + kstep; const char* b3 = b2 + kstep;
            if (last && has_next) S.a_ready(nxt);
            if constexpr (SP2) {
            PG8_LDB(B0, 0, 0); PG8_LDB(B1, 0, 1); PG8_SCHED; PG8_LDA(At, 0, 0); PG8_STAGE_A(PG8_SA(1, 1), a1, 1, false);
            PG8_WAIT_V(8); PG8_WAIT_L(0); PG8_BAR; PG8_MMA(0, 0, At, B0); PG8_MMA(0, 1, At, B1); PG8_BAR; PG8_SCHED;
            PG8_LDA(At, 0, 1); PG8_STAGE(PG8_SB(0, 0), b2, voffB); PG8_STAGE(PG8_SB(0, 1), b2 + hstep, voffB); PG8_STAGE_A(PG8_SA(0, 0), a2, 0, last);
            PG8_WAIT_V(8); PG8_WAIT_L(0); PG8_BAR; PG8_MMA(1, 0, At, B0); PG8_MMA(1, 1, At, B1); PG8_BAR; PG8_SCHED;
            PG8_LDB(B0, 1, 0); PG8_LDB(B1, 1, 1); PG8_SCHED; PG8_LDA(At, 1, 0); PG8_STAGE_A(PG8_SA(0, 1), a2, 1, last);
            PG8_WAIT_V(8); PG8_WAIT_L(0); PG8_BAR; PG8_MMA(0, 0, At, B0); PG8_MMA(0, 1, At, B1); PG8_BAR; PG8_SCHED;
            PG8_LDA(At, 1, 1); PG8_STAGE(PG8_SB(1, 0), b3, voffB); PG8_STAGE(PG8_SB(1, 1), b3 + hstep, voffB); PG8_STAGE_A(PG8_SA(1, 0), a3, 0, last);
            PG8_WAIT_V(8); PG8_WAIT_L(0); PG8_BAR; PG8_MMA(1, 0, At, B0); PG8_MMA(1, 1, At, B1); PG8_BAR; PG8_SCHED;
            } else {
            PG8_LDB(B0, 0, 0); PG8_SCHED; PG8_LDA(At, 0, 0); PG8_STAGE_A(PG8_SA(1, 1), a1, 1, false);
            PG8_WAIT_L(8); PG8_BAR; PG8_WAIT_L(0); PG8_MMA(0, 0, At, B0); PG8_BAR; PG8_SCHED;
            PG8_LDB(B1, 0, 1); PG8_STAGE(PG8_SB(0, 0), b2, voffB);
            PG8_BAR; PG8_WAIT_L(0); PG8_MMA(0, 1, At, B1); PG8_BAR;
            PG8_LDA(At, 0, 1); PG8_STAGE_A(PG8_SA(0, 0), a2, 0, last);
            PG8_BAR; PG8_WAIT_L(0); PG8_MMA(1, 0, At, B0); PG8_BAR; PG8_SCHED;
            PG8_STAGE(PG8_SB(0, 1), b2 + hstep, voffB);
            PG8_WAIT_V(6); PG8_BAR; PG8_MMA(1, 1, At, B1); PG8_BAR;
            PG8_LDB(B0, 1, 0); PG8_SCHED; PG8_LDA(At, 1, 0); PG8_STAGE_A(PG8_SA(0, 1), a2, 1, last);
            PG8_WAIT_L(8); PG8_BAR; PG8_WAIT_L(0); PG8_MMA(0, 0, At, B0); PG8_BAR; PG8_SCHED;
            PG8_LDB(B1, 1, 1); PG8_STAGE(PG8_SB(1, 0), b3, voffB);
            PG8_BAR; PG8_WAIT_L(0); PG8_MMA(0, 1, At, B1); PG8_BAR;
            PG8_LDA(At, 1, 1); PG8_STAGE_A(PG8_SA(1, 0), a3, 0, last);
            PG8_BAR; PG8_WAIT_L(0); PG8_MMA(1, 0, At, B0); PG8_BAR; PG8_SCHED;
            PG8_STAGE(PG8_SB(1, 1), b3 + hstep, voffB);
            PG8_WAIT_V(6); PG8_BAR; PG8_MMA(1, 1, At, B1); PG8_BAR;
            }
        }
        if constexpr (ALIGN_EPI) { if (wr == 0) PG8_BAR; }
        if constexpr (!Epi::AFTER_DRAIN) { E(acc, cur, wr, wc, fr, fq); S.done(cur); }
        if (!has_next) break;
#pragma unroll
        for (int a = 0; a < 2; ++a)
#pragma unroll
            for (int b = 0; b < 2; ++b)
#pragma unroll
                for (int m = 0; m < 4; ++m)
#pragma unroll
                    for (int n = 0; n < 2; ++n) acc[a][b][m][n] = (f32x4){0.f, 0.f, 0.f, 0.f};
        cur = nxt; cA = nA; cB = nB; ++ui;
        if constexpr (GATHER) { _Pragma("unroll") for (int _h = 0; _h < 2; ++_h) _Pragma("unroll") for (int _i = 0; _i < 2; ++_i) vgC[_h][_i] = vgN[_h][_i]; }
        if constexpr (ALIGN_EPI) { if (wr == 1) PG8_BAR; }
    }
    PG8_WAIT_V(0);
    if constexpr (!ALIGN_EPI) { if (wr == 0) PG8_BAR; }
    PG8_BAR;
    if constexpr (Epi::AFTER_DRAIN) { E.fused(acc, cur, wr, wc, fr, fq, lds, wid, lane); S.done(cur); }
#undef PG8_SA
#undef PG8_SB
#undef PG8_STAGE
#undef PG8_STAGE_A
#undef PG8_GOFFS
#undef PG8_LDA
#undef PG8_LDB
#undef PG8_MMA
#undef PG8_WAIT_V
#undef PG8_WAIT_L
#undef PG8_BAR
#undef PG8_SCHED
}
}
#define LAS __attribute__((address_space(3)))
typedef unsigned short bf16_t;
typedef float f32x4 __attribute__((ext_vector_type(4)));
typedef float f32x2 __attribute__((ext_vector_type(2)));
typedef unsigned u32x4 __attribute__((ext_vector_type(4)));
typedef unsigned u32x2 __attribute__((ext_vector_type(2)));

constexpr int NB = 16;
constexpr int SEQ = 2048, CTXL = 256, SCAN = SEQ + CTXL;
constexpr int DM = 2048;
constexpr int NLAT = NB * SEQ;
constexpr int NCTX = NB * CTXL;
constexpr int NTOK = NLAT + NCTX;
constexpr int NPC = 6144;
constexpr int GW = 512;
constexpr int NEXP = 16;
constexpr int DFF = 1024;
constexpr int MPAD = 2 * NTOK + NEXP * 256;
constexpr int NRCH = NTOK / 128;
constexpr float EPS = 1e-6f;

constexpr size_t al256(size_t x) { return (x + 255) & ~(size_t)255; }
constexpr size_t OFF_CTL = 0;
constexpr size_t CTL_BYTES = 65536;
constexpr size_t OFF_MOD = OFF_CTL + CTL_BYTES;
constexpr size_t OFF_LB = OFF_MOD + al256((size_t)2 * 17 * 12288 * 4);
constexpr size_t OFF_RE0 = OFF_LB + al256((size_t)2 * 2 * 512 * 4);
constexpr size_t OFF_RE1 = OFF_RE0 + (size_t)NTOK * 4;
constexpr size_t OFF_RW0 = OFF_RE1 + (size_t)NTOK * 4;
constexpr size_t OFF_RW1 = OFF_RW0 + (size_t)NTOK * 4;
constexpr size_t OFF_RP0 = OFF_RW1 + (size_t)NTOK * 4;
constexpr size_t OFF_RP1 = OFF_RP0 + (size_t)NTOK * 4;
constexpr size_t OFF_BLKCNT = OFF_RP1 + (size_t)NTOK * 4;
constexpr size_t OFF_SORTTOK = OFF_BLKCNT + al256((size_t)NRCH * 16 * 4);
constexpr size_t OFF_SORTGATE = OFF_SORTTOK + al256((size_t)MPAD * 4);
constexpr size_t OFF_TILE = OFF_SORTGATE + al256((size_t)MPAD * 4);
constexpr size_t OFF_WGLU = OFF_TILE + 2048;
constexpr size_t OFF_X = al256(OFF_WGLU + (size_t)2 * 512 * 512 * 2);
constexpr size_t OFF_HB = OFF_X + (size_t)NTOK * DM * 4;
constexpr size_t OFF_P = OFF_HB + (size_t)NTOK * DM * 2;
constexpr size_t P_REGION = (size_t)MPAD * DM * 2 + (size_t)MPAD * DFF * 2;
constexpr size_t OFF_YBUF = OFF_P;
constexpr size_t OFF_HE = OFF_P + (size_t)MPAD * DM * 2;
constexpr size_t OFF_WIN = OFF_P + P_REGION;
constexpr size_t OFF_WOUT = OFF_WIN + (size_t)2 * NPC * DM * 2;
constexpr size_t OFF_WMOE = OFF_WOUT + (size_t)2 * DM * DM * 2;
constexpr size_t OFF_W1 = OFF_WMOE;
constexpr size_t OFF_W2 = OFF_WMOE + (size_t)NEXP * 2048 * 2048 * 2;
constexpr size_t OFF_PB = OFF_WMOE + (size_t)NEXP * 2048 * 2048 * 2 + (size_t)NEXP * 2048 * 1024 * 2;
constexpr size_t OFF_GY = OFF_PB + (size_t)NTOK * DM * 2;
constexpr size_t WS_END = OFF_GY + (size_t)NTOK * 512 * 2;
static_assert((size_t)NTOK * NPC * 2 <= P_REGION, "P fits");

struct Params {
    const float *x, *c, *ctx, *c_ctx, *norm_mix_g, *norm_ffn_g, *w_mod, *b_mod, *w_in, *w_out;
    const float *s5_lam_re, *s5_lam_im, *s5_log_dt, *s5_b_re, *s5_b_im, *s5_c_re, *s5_c_im, *s5_d, *s5_glu_w, *s5_glu_b;
    const float *lru_conv_w, *lru_conv_b, *lru_wa, *lru_ba, *lru_wx, *lru_bx, *lru_lam, *hgrn_lb, *router_w, *router_bias;
    const float *moe_w_gate, *moe_w_up, *moe_w_down, *final_g;
    float* out; unsigned char* ws;
};

constexpr int PBLK = 128;
__device__ __forceinline__ size_t p_off(int row, int col) { return ((size_t)(col >> 7) * NTOK + (size_t)row) * PBLK + (col & 127); }
__device__ __forceinline__ float bf2f(unsigned v) { return __uint_as_float(v << 16); }
__device__ __forceinline__ float bflo(unsigned w) { return __uint_as_float(w << 16); }
__device__ __forceinline__ float bfhi(unsigned w) { return __uint_as_float(w & 0xffff0000u); }
typedef __bf16 bf16x2_c __attribute__((ext_vector_type(2)));
__device__ __forceinline__ unsigned pk2(float lo, float hi) { const f32x2 v = {lo, hi}; return __builtin_bit_cast(unsigned, __builtin_convertvector(v, bf16x2_c)); }
__device__ __forceinline__ unsigned f2bf(float f) { return pk2(f, f) & 0xffffu; }
__device__ __forceinline__ float frcp(float x) { return __builtin_amdgcn_rcpf(x); }
__device__ __forceinline__ float sigmoidf_(float x) { return frcp(1.0f + __expf(-x)); }
__device__ __forceinline__ float siluf_(float x) { return x * frcp(1.0f + __expf(-x)); }
__device__ __forceinline__ float geluf_(float x) {
    const float u = 0.7978845608028654f * (x + 0.044715f * x * x * x);
    return x * frcp(1.0f + __expf(-2.0f * u));
}
__device__ __forceinline__ float shx(float v, int mask, int lane) { return __int_as_float(__builtin_amdgcn_ds_bpermute((lane ^ mask) << 2, __float_as_int(v))); }
__device__ __forceinline__ float wave_sum(float v, int lane) {
#pragma unroll
    for (int o = 1; o < 64; o <<= 1) v += shx(v, o, lane);
    return v;
}
__device__ __forceinline__ float rdlane(float v, int l) { return __int_as_float(__builtin_amdgcn_readlane(__float_as_int(v), l)); }
__device__ __forceinline__ int scan_row(int b, int dir, int s) {
    if (s < CTXL) return NLAT + b * CTXL + (dir ? (CTXL - 1 - s) : s);
    const int l = s - CTXL; return b * SEQ + (dir ? (SEQ - 1 - l) : l);
}
__device__ __forceinline__ int mod_row(int row) { return row < NLAT ? (row >> 11) : 16; }
#define XB_TMO      128
#define XB_XCNT(j)  (256  + 64 * (j))
#define XB_XSUB(j)  (1280 + 64 * (j))
#define XB_XGEN(j)  (2304 + 64 * (j))
#define XB_TOP      3328
#define XB_TOPGEN   3392
#define XCD_BAR_WORDS 3456
#define XB_SPIN_CAP (1u << 18)

__device__ __forceinline__ unsigned xb_ld(unsigned* p)              { return __hip_atomic_load(p, __ATOMIC_RELAXED, __HIP_MEMORY_SCOPE_AGENT); }
__device__ __forceinline__ unsigned xb_add(unsigned* p, unsigned v) { return __hip_atomic_fetch_add(p, v, __ATOMIC_RELAXED, __HIP_MEMORY_SCOPE_AGENT); }
__device__ __forceinline__ unsigned xb_xcc_id() { return (unsigned)__builtin_amdgcn_s_getreg((3 << 11) | 20) & 0xFu; }
#define XB_SPIN(cond, bar) do { unsigned _sp = 0; while (cond) { __builtin_amdgcn_s_sleep(1); \
    if ((++_sp & 255u) == 0u) { if (xb_ld(&(bar)[XB_TMO])) break; if (_sp > XB_SPIN_CAP) { atomicAdd(&(bar)[XB_TMO], 1u); break; } } } } while (0)

struct XcdBarrier {
    unsigned* bar; unsigned x;
    volatile LAS unsigned* st;
};

__device__ __forceinline__ XcdBarrier xcd_barrier_post(unsigned* bar, volatile LAS unsigned* st) {
    XcdBarrier b; b.bar = bar; b.x = xb_xcc_id(); b.st = st;
    if (threadIdx.x == 0) (void)xb_add(&bar[XB_XCNT(b.x)], 1u);
    return b;
}
__device__ __forceinline__ void xcd_barrier_complete(unsigned* bar, unsigned x, unsigned& nloc, unsigned& nx) {
    const unsigned G = gridDim.x * gridDim.y * gridDim.z;
    unsigned sum, cnt, mine, sp = 0u;
    for (;;) {
        sum = 0u; cnt = 0u; mine = 0u;
#pragma unroll
        for (unsigned j = 0; j < 16; ++j) { const unsigned c = xb_ld(&bar[XB_XCNT(j)]); sum += c; cnt += (c > 0u) ? 1u : 0u; mine = (j == x) ? c : mine; }
        if (sum == G) break;
        __builtin_amdgcn_s_sleep(1);
        if ((++sp & 255u) == 0u) { if (xb_ld(&bar[XB_TMO])) break; if (sp > XB_SPIN_CAP) { atomicAdd(&bar[XB_TMO], 1u); break; } }
    }
    nloc = mine > 0u ? mine : 1u; nx = cnt > 0u ? cnt : 1u;
}

__device__ __forceinline__ void xcd_barrier(const XcdBarrier& b) {
    asm volatile("s_waitcnt vmcnt(0)" ::: "memory");
    __syncthreads();
    if (threadIdx.x == 0) {
        unsigned* bar = b.bar;
        __builtin_amdgcn_s_waitcnt(0);
        unsigned nloc = b.st[0], nx = b.st[1];
        if (nloc == 0u) { xcd_barrier_complete(bar, b.x, nloc, nx); b.st[0] = nloc; b.st[1] = nx; }
        const unsigned old = xb_add(&bar[XB_XSUB(b.x)], 1u);
        const unsigned gen = old / nloc;
        if (old + 1u == (gen + 1u) * nloc) {
            __builtin_amdgcn_fence(__ATOMIC_RELEASE, "agent");
            asm volatile("s_waitcnt vmcnt(0)" ::: "memory");
            const unsigned og = xb_add(&bar[XB_TOP], 1u);
            const unsigned tg = og / nx;
            if (og + 1u == (tg + 1u) * nx) xb_add(&bar[XB_TOPGEN], 1u);
            else XB_SPIN(xb_ld(&bar[XB_TOPGEN]) == tg, bar);
            __builtin_amdgcn_fence(__ATOMIC_ACQUIRE, "agent");
            xb_add(&bar[XB_XGEN(b.x)], 1u);
            asm volatile("s_waitcnt vmcnt(0)" ::: "memory");
        } else {
            XB_SPIN(xb_ld(&bar[XB_XGEN(b.x)]) == gen, bar);
            __builtin_amdgcn_fence(__ATOMIC_ACQUIRE, "agent");
            asm volatile("s_waitcnt vmcnt(0)" ::: "memory");
        }
    }
    __syncthreads();
}

namespace pg8 {
struct EpiPlainBf16 {
    static constexpr bool PERM = true, AFTER_DRAIN = false;
    bf16_t* O; int ldc; int silu_lo, silu_hi;
    __device__ __forceinline__ void operator()(const f32x4 (&acc)[2][2][4][2], const Unit& u, int wr, int wc, int fr, int fq) const {
        const int row0 = u.pm * BM + wr * 64 + fr, col0 = u.pn * BM + wc * 32 + 8 * fq;
        const bool act = u.pn >= silu_lo && u.pn < silu_hi;
#pragma unroll
        for (int ai = 0; ai < 2; ++ai)
#pragma unroll
            for (int m = 0; m < 4; ++m) { const int row = row0 + ai * HALF + m * 16;
                bf16_t* rowp = ldc ? O + (size_t)row * ldc + col0 : O + ((size_t)(2 * u.pn) * NTOK + row) * 128 + wc * 32 + 8 * fq;
                const size_t bjstep = ldc ? (size_t)HALF : (size_t)NTOK * 128;
#pragma unroll
                for (int bj = 0; bj < 2; ++bj) { f32x4 v0 = acc[ai][bj][m][0], v1 = acc[ai][bj][m][1];
                    if (act) { v0 = (f32x4){siluf_(v0[0]), siluf_(v0[1]), siluf_(v0[2]), siluf_(v0[3])}; v1 = (f32x4){siluf_(v1[0]), siluf_(v1[1]), siluf_(v1[2]), siluf_(v1[3])}; }
                    u32x4 w; w.x = cvt_pk_bf16(v0[0], v0[1]); w.y = cvt_pk_bf16(v0[2], v0[3]); w.z = cvt_pk_bf16(v1[0], v1[1]); w.w = cvt_pk_bf16(v1[2], v1[3]);
                    *(u32x4*)(rowp + bj * bjstep) = w; } }
    }
};
struct EpiResid {
    static constexpr bool PERM = true, AFTER_DRAIN = false;
    bf16_t* X; const float* gate; const float* xin; const float* cin;
    __device__ __forceinline__ void operator()(const f32x4 (&acc)[2][2][4][2], const Unit& u, int wr, int wc, int fr, int fq) const {
        const int row0 = u.pm * BM + wr * 64 + fr, col0 = u.pn * BM + wc * 32 + 8 * fq;
        const int bm = (u.pm < (NLAT / 256)) ? (u.pm >> 3) : 16;
        const float* gv = gate + (size_t)bm * 12288 + col0;
        const float* src = xin ? ((u.pm < (NLAT / 256)) ? xin + (size_t)row0 * DM : cin + (size_t)(row0 - NLAT) * DM) + col0 : nullptr;
        f32x4 g4[2][2];
#pragma unroll
        for (int bj = 0; bj < 2; ++bj)
#pragma unroll
            for (int n = 0; n < 2; ++n) g4[bj][n] = *(const f32x4*)(gv + bj * HALF + 4 * n);
#pragma unroll
        for (int ai = 0; ai < 2; ++ai)
#pragma unroll
            for (int m = 0; m < 4; ++m) { const size_t ro = (size_t)(ai * HALF + m * 16) * DM; bf16_t* xp = X + (size_t)row0 * DM + ro + col0;
#pragma unroll
                for (int bj = 0; bj < 2; ++bj) { f32x4 v0, v1;
                    if (src) { v0 = *(const f32x4*)(src + ro + bj * HALF); v1 = *(const f32x4*)(src + ro + bj * HALF + 4); }
                    else { const u32x4 w = *(const u32x4*)(xp + bj * HALF); v0 = (f32x4){bflo(w.x), bfhi(w.x), bflo(w.y), bfhi(w.y)}; v1 = (f32x4){bflo(w.z), bfhi(w.z), bflo(w.w), bfhi(w.w)}; }
                    v0 = v0 + g4[bj][0] * acc[ai][bj][m][0]; v1 = v1 + g4[bj][1] * acc[ai][bj][m][1];
                    u32x4 o; o.x = cvt_pk_bf16(v0[0], v0[1]); o.y = cvt_pk_bf16(v0[2], v0[3]); o.z = cvt_pk_bf16(v1[0], v1[1]); o.w = cvt_pk_bf16(v1[2], v1[3]);
                    *(u32x4*)(xp + bj * HALF) = o; } }
    }
};
struct EpiGlu {
    static constexpr bool PERM = true, AFTER_DRAIN = false;
    bf16_t* O; int ldo; const bf16_t* GY; const float* bias;
    __device__ __forceinline__ void operator()(const f32x4 (&acc)[2][2][4][2], const Unit& u, int wr, int wc, int fr, int fq) const {
        const int row0 = u.pm * BM + wr * 64 + fr, col0 = u.pn * BM + wc * 32 + 8 * fq;
        f32x4 bv[2][2];
#pragma unroll
        for (int bj = 0; bj < 2; ++bj)
#pragma unroll
            for (int n = 0; n < 2; ++n) bv[bj][n] = *(const f32x4*)(bias + col0 + bj * HALF + 4 * n);
#pragma unroll
        for (int ai = 0; ai < 2; ++ai)
#pragma unroll
            for (int m = 0; m < 4; ++m) { const int row = row0 + ai * HALF + m * 16;
#pragma unroll
                for (int bj = 0; bj < 2; ++bj) { const f32x4 v0 = acc[ai][bj][m][0] + bv[bj][0], v1 = acc[ai][bj][m][1] + bv[bj][1];
                    const u32x4 g = *(const u32x4*)(GY + (size_t)row * 512 + col0 + bj * HALF);
                    float o[8];
                    o[0] = bflo(g.x) * sigmoidf_(v0[0]); o[1] = bfhi(g.x) * sigmoidf_(v0[1]); o[2] = bflo(g.y) * sigmoidf_(v0[2]); o[3] = bfhi(g.y) * sigmoidf_(v0[3]);
                    o[4] = bflo(g.z) * sigmoidf_(v1[0]); o[5] = bfhi(g.z) * sigmoidf_(v1[1]); o[6] = bflo(g.w) * sigmoidf_(v1[2]); o[7] = bfhi(g.w) * sigmoidf_(v1[3]);
                    u32x4 w; w.x = cvt_pk_bf16(o[0], o[1]); w.y = cvt_pk_bf16(o[2], o[3]); w.z = cvt_pk_bf16(o[4], o[5]); w.w = cvt_pk_bf16(o[6], o[7]);
                    *(u32x4*)(O + (size_t)row * ldo + col0 + bj * HALF) = w; } }
    }
};
struct EpiSwiGlu {
    static constexpr bool PERM = true, AFTER_DRAIN = false;
    bf16_t* HE;
    __device__ __forceinline__ void operator()(const f32x4 (&acc)[2][2][4][2], const Unit& u, int wr, int wc, int fr, int fq) const {
        const int row0 = u.pm * BM + wr * 64 + fr, col0 = (u.pn & 7) * HALF + wc * 32 + 8 * fq;
#pragma unroll
        for (int ai = 0; ai < 2; ++ai)
#pragma unroll
            for (int m = 0; m < 4; ++m) { const int row = row0 + ai * HALF + m * 16;
                const f32x4 g0 = acc[ai][0][m][0], g1 = acc[ai][0][m][1], u0 = acc[ai][1][m][0], u1 = acc[ai][1][m][1];
                u32x4 w;
                w.x = cvt_pk_bf16(siluf_(g0[0]) * u0[0], siluf_(g0[1]) * u0[1]); w.y = cvt_pk_bf16(siluf_(g0[2]) * u0[2], siluf_(g0[3]) * u0[3]);
                w.z = cvt_pk_bf16(siluf_(g1[0]) * u1[0], siluf_(g1[1]) * u1[1]); w.w = cvt_pk_bf16(siluf_(g1[2]) * u1[2], siluf_(g1[3]) * u1[3]);
                *(u32x4*)(HE + (size_t)row * DFF + col0) = w; }
    }
};
struct EpiScaleRow {
    static constexpr bool PERM = true, AFTER_DRAIN = false;
    bf16_t* YB; const float* rowgate;
    __device__ __forceinline__ void operator()(const f32x4 (&acc)[2][2][4][2], const Unit& u, int wr, int wc, int fr, int fq) const {
        const int row0 = u.pm * BM + wr * 64 + fr, col0 = (u.pn & 7) * BM + wc * 32 + 8 * fq;
#pragma unroll
        for (int ai = 0; ai < 2; ++ai)
#pragma unroll
            for (int m = 0; m < 4; ++m) { const int row = row0 + ai * HALF + m * 16; const float rg = rowgate[row];
#pragma unroll
                for (int bj = 0; bj < 2; ++bj) { const f32x4 v0 = acc[ai][bj][m][0] * rg, v1 = acc[ai][bj][m][1] * rg;
                    u32x4 w; w.x = cvt_pk_bf16(v0[0], v0[1]); w.y = cvt_pk_bf16(v0[2], v0[3]); w.z = cvt_pk_bf16(v1[0], v1[1]); w.w = cvt_pk_bf16(v1[2], v1[3]);
                    *(u32x4*)(YB + (size_t)row * DM + col0 + bj * HALF) = w; } }
    }
};
struct MoeOrder {
    const int* tile_e; int ntiles, G, c;
    __device__ __forceinline__ bool next(int i, Unit& u) const {
        const long L = (long)i * G + c; const int nwg = ntiles * 8; if (L >= nwg) return false;
        int wgid = (int)L; { const int q = nwg / NXCD, r = nwg % NXCD, xcd = wgid % NXCD, off = wgid / NXCD; wgid = (xcd < r ? xcd * (q + 1) : r * (q + 1) + (xcd - r) * q) + off; }
        const int t = wgid >> 3; u.pm = t; u.pn = tile_e[t] * 8 + (wgid & 7); return true;
    }
    __device__ __forceinline__ void a_ready(const Unit&) const {}
    __device__ __forceinline__ void done(const Unit&) const {}
};
struct InOrderLast {
    StaticOrder lat; int G, c;
    __device__ __forceinline__ void init(int G_, int c_) { lat.init(NLAT, NPC, G_, c_); G = G_; c = c_; }
    __device__ __forceinline__ bool next(int i, Unit& u) const {
        const long L = (long)i * G + c; const int nlat = (NLAT / BM) * (NPC / BM);
        if (L < nlat) return lat.next(i, u);
        const int idx = (int)(L - nlat); if (idx >= (NCTX / BM) * 14) return false;
        const int k = idx % 14, sec = k >> 1;
        const int part = sec == 0 ? 0 : sec == 1 ? 1 : sec == 2 ? 4 : sec == 3 ? 5 : sec == 4 ? 6 : sec == 5 ? 9 : 10;
        u.pm = NLAT / BM + idx / 14; u.pn = part * 2 + (k & 1); return true;
    }
    __device__ __forceinline__ void a_ready(const Unit&) const {}
    __device__ __forceinline__ void done(const Unit&) const {}
};
}
#define WS_PTR(T, off) ((T*)(P.ws + (off)))

__device__ __forceinline__ void phase_mod(const Params& P, int l0, int l1, LAS unsigned char* lds, int bid, int nblk, int wv) {
    const int tid = tid_(wv);
    LAS float* sc = (LAS float*)lds;
    float* MOD = WS_PTR(float, OFF_MOD);
    if (bid == 0 && l0 == 0) {
        float* LB = WS_PTR(float, OFF_LB);
        for (int i = tid; i < 2 * 512; i += 512) { const int dir = i >> 9, ch = i & 511;
            const float l0 = P.hgrn_lb[(dir * 2 + 0) * 512 + ch], l1 = P.hgrn_lb[(dir * 2 + 1) * 512 + ch];
            LB[(0 * 2 + dir) * 512 + ch] = 0.f; LB[(1 * 2 + dir) * 512 + ch] = 1.0f / (1.0f + expf(l0 - l1)); }
    }
    for (int unit = l0 * 48 + bid; unit < l1 * 48; unit += nblk) {
        const int layer = unit / 48, cb = (unit % 48) * 256;
        __syncthreads();
        for (int i = tid; i < 17 * 2048; i += 512) { const int r = i >> 11, k = i & 2047; const float v = r < 16 ? P.c[r * 2048 + k] : P.c_ctx[k]; sc[i] = v / (1.0f + expf(-v)); }
        __syncthreads();
        const int lane = tid & 63, w = tid >> 6;
        f32x4 acc[17];
#pragma unroll
        for (int r = 0; r < 17; ++r) acc[r] = (f32x4){0.f, 0.f, 0.f, 0.f};
        const float* wp = P.w_mod + ((size_t)layer * 2048 + w * 256) * 12288 + cb + 4 * lane;
        for (int k8 = 0; k8 < 256; k8 += 8) {
            f32x4 wv_[8];
#pragma unroll
            for (int u = 0; u < 8; ++u) wv_[u] = *(const f32x4*)(wp + (size_t)(k8 + u) * 12288);
#pragma unroll
            for (int u4 = 0; u4 < 8; u4 += 4) {
#pragma unroll
                for (int r = 0; r < 17; ++r) { const f32x4 s4 = *(const LAS f32x4*)(sc + r * 2048 + w * 256 + k8 + u4);
                    acc[r] += wv_[u4] * s4[0] + wv_[u4 + 1] * s4[1] + wv_[u4 + 2] * s4[2] + wv_[u4 + 3] * s4[3]; }
            }
        }
        __syncthreads();
        LAS f32x4* red = (LAS f32x4*)lds;
#pragma unroll
        for (int r = 0; r < 17; ++r) red[(w * 17 + r) * 64 + lane] = acc[r];
        __syncthreads();
        for (int i = tid; i < 17 * 64; i += 512) { const int r = i >> 6, l4 = i & 63; f32x4 sum = red[(0 * 17 + r) * 64 + l4];
#pragma unroll
            for (int ww = 1; ww < 8; ++ww) sum += red[(ww * 17 + r) * 64 + l4];
            const f32x4 bm4 = *(const f32x4*)(P.b_mod + layer * 12288 + cb + 4 * l4);
            *(f32x4*)(MOD + ((size_t)layer * 17 + r) * 12288 + cb + 4 * l4) = sum + bm4; }
    }
    __syncthreads();
}

__device__ __forceinline__ void transpose_item(const float* W, int N, int k0, int n0, bf16_t* WT, int K, int drow0, LAS float* scr, int lane) {
    f32x4 v[8];
#pragma unroll
    for (int i = 0; i < 8; ++i) v[i] = *(const f32x4*)(W + (size_t)(k0 + 8 * i + (lane >> 3)) * N + n0 + 4 * (lane & 7));
#pragma unroll
    for (int i = 0; i < 8; ++i) { LAS float* d = scr + (8 * i + (lane >> 3)) * 33 + 4 * (lane & 7); d[0] = v[i][0]; d[1] = v[i][1]; d[2] = v[i][2]; d[3] = v[i][3]; }
    asm volatile("s_waitcnt lgkmcnt(0)" ::: "memory");
    const int c = lane & 7;
#pragma unroll
    for (int j = 0; j < 4; ++j) { const int n = (lane >> 3) + 8 * j; const LAS float* s = scr + (8 * c) * 33 + n;
        u32x4 o; o.x = pk2(s[0 * 33], s[1 * 33]); o.y = pk2(s[2 * 33], s[3 * 33]); o.z = pk2(s[4 * 33], s[5 * 33]); o.w = pk2(s[6 * 33], s[7 * 33]);
        *(u32x4*)(WT + (size_t)(drow0 + n) * K + k0 + 8 * c) = o; }
    asm volatile("s_waitcnt lgkmcnt(0)" ::: "memory");
}
__device__ __forceinline__ void phase_convert_small(const Params& P, int l0, int l1, LAS unsigned char* lds, int bid, int nblk, int wv) {
    const int tid = tid_(wv), lane = tid & 63, wave = __builtin_amdgcn_readfirstlane(tid >> 6);
    LAS float* scr = (LAS float*)(lds + wave * 16384);
    constexpr int I_IN = 32 * 192, I_OUT = 32 * 64, I_GLU = 8 * 16, I_L = I_IN + I_OUT + I_GLU;
    for (int it = l0 * I_L + bid * 8 + wave; it < l1 * I_L; it += nblk * 8) {
        const int layer = it / I_L; int r = it % I_L;
        if (r < I_IN) { const int kb = r / 192, nb = r % 192; transpose_item(P.w_in + (size_t)layer * DM * NPC, NPC, 64 * kb, 32 * nb, WS_PTR(bf16_t, OFF_WIN) + (size_t)layer * NPC * DM, DM, 32 * nb, scr, lane); continue; }
        r -= I_IN;
        if (r < I_OUT) { const int kb = r / 64, nb = r % 64; transpose_item(P.w_out + (size_t)layer * DM * DM, DM, 64 * kb, 32 * nb, WS_PTR(bf16_t, OFF_WOUT) + (size_t)layer * DM * DM, DM, 32 * nb, scr, lane); continue; }
        r -= I_OUT;
        { const int kb = r / 16, nb = r % 16; transpose_item(P.s5_glu_w + (size_t)layer * 512 * 512, 512, 64 * kb, 32 * nb, WS_PTR(bf16_t, OFF_WGLU) + (size_t)layer * 512 * 512, 512, 32 * nb, scr, lane); }
    }
}
struct TItem { const float* W; int N, k0, n0; bf16_t* WT; int K, drow0; };
__device__ __forceinline__ void titem_load(const TItem& t, int lane, f32x4 (&v)[8]) {
#pragma unroll
    for (int i = 0; i < 8; ++i) v[i] = __builtin_nontemporal_load((const f32x4*)(t.W + (size_t)(t.k0 + 8 * i + (lane >> 3)) * t.N + t.n0 + 4 * (lane & 7)));
}
__device__ __forceinline__ void titem_store(const TItem& t, LAS float* scr, int lane, const f32x4 (&v)[8]) {
#pragma unroll
    for (int i = 0; i < 8; ++i) { LAS float* d = scr + (8 * i + (lane >> 3)) * 33 + 4 * (lane & 7); d[0] = v[i][0]; d[1] = v[i][1]; d[2] = v[i][2]; d[3] = v[i][3]; }
    asm volatile("s_waitcnt lgkmcnt(0)" ::: "memory");
    const int c = lane & 7;
#pragma unroll
    for (int j = 0; j < 4; ++j) { const int n = (lane >> 3) + 8 * j; const LAS float* s = scr + (8 * c) * 33 + n;
        u32x4 o; o.x = pk2(s[0 * 33], s[1 * 33]); o.y = pk2(s[2 * 33], s[3 * 33]); o.z = pk2(s[4 * 33], s[5 * 33]); o.w = pk2(s[6 * 33], s[7 * 33]);
        *(u32x4*)(t.WT + (size_t)(t.drow0 + n) * t.K + t.k0 + 8 * c) = o; }
    asm volatile("s_waitcnt lgkmcnt(0)" ::: "memory");
}
__device__ __forceinline__ TItem moe_item(const Params& P, int layer, int it) {
    constexpr int I_G = 32 * 32, I_E = 3 * I_G;
    const int e = it / I_E; int r = it % I_E; TItem t;
    if (r < 2 * I_G) { const int up = r / I_G; r %= I_G; const int kb = r / 32, nb = r % 32, n0 = 32 * nb;
        t.W = (up ? P.moe_w_up : P.moe_w_gate) + ((size_t)layer * NEXP + e) * DM * DFF; t.N = DFF; t.k0 = 64 * kb; t.n0 = n0;
        t.WT = WS_PTR(bf16_t, OFF_W1) + (size_t)e * 2048 * 2048; t.K = DM; t.drow0 = (n0 >> 7) * 256 + up * 128 + (n0 & 127);
    } else { r -= 2 * I_G; const int kb = r / 64, nb = r % 64;
        t.W = P.moe_w_down + ((size_t)layer * NEXP + e) * DFF * DM; t.N = DM; t.k0 = 64 * kb; t.n0 = 32 * nb;
        t.WT = WS_PTR(bf16_t, OFF_W2) + (size_t)e * 2048 * 1024; t.K = DFF; t.drow0 = 32 * nb; }
    return t;
}
__device__ __forceinline__ void convert_moe_queue(const Params& P, int layer, LAS float* scr, LAS int* cq, int bid, int nblk, int lane) {
    constexpr int NIT = NEXP * 3 * 32 * 32;
    const bool wtd = nblk == 256; constexpr int PH = 80, PR = 112; static_assert(128 * (PH + PR) * 2 == NIT, "conversion shares");
    auto grab = [&]() { int k = 0; if (lane == 0) k = atomicAdd((int*)cq, 1); k = __builtin_amdgcn_readfirstlane(k);
        if (wtd) { const bool hg = bid < 128; if (k >= (hg ? PH : PR)) return NIT; return 2 * (hg ? k * 128 + bid : 128 * PH + k * 128 + (bid - 128)); }
        return (2 * k) * nblk + bid; };
    auto second = [&](int it) { return wtd ? it + 1 : (it + nblk < NIT ? it + nblk : it); };
    int it = grab(); if (it >= NIT) return;
    f32x4 va[8], vb[8], vc[8], vd[8];
    TItem ta = moe_item(P, layer, it), tb = moe_item(P, layer, second(it));
    titem_load(ta, lane, va); titem_load(tb, lane, vb);
    for (;;) {
        const int it2 = grab(); const bool ok2 = it2 < NIT; const int i2 = ok2 ? it2 : it;
        const TItem tc = moe_item(P, layer, i2), td = moe_item(P, layer, second(i2));
        titem_load(tc, lane, vc); titem_load(td, lane, vd);
        titem_store(ta, scr, lane, va); titem_store(tb, scr, lane, vb);
        if (!ok2) break;
        const int it3 = grab(); const bool ok3 = it3 < NIT; const int i3 = ok3 ? it3 : it2;
        ta = moe_item(P, layer, i3); tb = moe_item(P, layer, second(i3));
        titem_load(ta, lane, va); titem_load(tb, lane, vb);
        titem_store(tc, scr, lane, vc); titem_store(td, scr, lane, vd);
        if (!ok3) break;
        it = it3;
    }
}

__device__ __forceinline__ f32x4 ldx4(const bf16_t* p) { const u32x2 w = *(const u32x2*)p; return (f32x4){bflo(w.x), bfhi(w.x), bflo(w.y), bfhi(w.y)}; }
__device__ __forceinline__ void add_moe_rows(const Params& P, int pl, int row, int p0, int p1, int lane, f32x4 (&xv)[8]) {
    const bf16_t* y0 = WS_PTR(const bf16_t, OFF_YBUF) + (size_t)p0 * DM, *y1 = WS_PTR(const bf16_t, OFF_YBUF) + (size_t)p1 * DM;
    const float* g5 = WS_PTR(const float, OFF_MOD) + ((size_t)pl * 17 + mod_row(row)) * 12288 + 5 * 2048;
    u32x2 a[8], b[8];
#pragma unroll
    for (int j = 0; j < 8; ++j) { a[j] = *(const u32x2*)(y0 + 4 * lane + 256 * j); b[j] = *(const u32x2*)(y1 + 4 * lane + 256 * j); }
#pragma unroll
    for (int j = 0; j < 8; ++j) { const f32x4 g = *(const f32x4*)(g5 + 4 * lane + 256 * j);
        xv[j][0] += g[0] * (bflo(a[j].x) + bflo(b[j].x)); xv[j][1] += g[1] * (bfhi(a[j].x) + bfhi(b[j].x)); xv[j][2] += g[2] * (bflo(a[j].y) + bflo(b[j].y)); xv[j][3] += g[3] * (bfhi(a[j].y) + bfhi(b[j].y)); }
}
__device__ __forceinline__ void add_moe_out(const Params& P, int pl, int row, int lane, f32x4 (&xv)[8]) {
    const int p0 = __builtin_amdgcn_readfirstlane(WS_PTR(const int, OFF_RP0)[row]), p1 = __builtin_amdgcn_readfirstlane(WS_PTR(const int, OFF_RP1)[row]);
    add_moe_rows(P, pl, row, p0, p1, lane, xv);
}
__device__ __forceinline__ float row_rstd(const f32x4 (&xv)[8], int lane) {
    float s = 0.f;
#pragma unroll
    for (int j = 0; j < 8; ++j) s += (xv[j][0] * xv[j][0] + xv[j][1] * xv[j][1]) + (xv[j][2] * xv[j][2] + xv[j][3] * xv[j][3]);
    return rsqrtf(wave_sum(s, lane) * (1.0f / DM) + EPS);
}

__device__ __forceinline__ void phase_norm1(const Params& P, int layer, int bid, int nblk, int wv) {
    const int tid = tid_(wv), lane = tid & 63, wave = __builtin_amdgcn_readfirstlane(tid >> 6);
    bf16_t* X = WS_PTR(bf16_t, OFF_X); bf16_t* HB = WS_PTR(bf16_t, OFF_HB);
    const float* gmix = P.norm_mix_g + layer * DM;
    for (int r0 = 2 * (bid * 8 + wave); r0 < NTOK; r0 += nblk * 16) {
        f32x4 xv[2][8];
#pragma unroll
        for (int u = 0; u < 2; ++u) { const int row = r0 + u;
            if (layer == 0) { const float* src = row < NLAT ? P.x + (size_t)row * DM : P.ctx + (size_t)(row - NLAT) * DM;
#pragma unroll
                for (int j = 0; j < 8; ++j) xv[u][j] = *(const f32x4*)(src + 4 * lane + 256 * j); }
            else {
#pragma unroll
                for (int j = 0; j < 8; ++j) xv[u][j] = ldx4(X + (size_t)row * DM + 4 * lane + 256 * j); } }
        if (layer > 0) {
            const int pa0 = WS_PTR(const int, OFF_RP0)[r0], pa1 = WS_PTR(const int, OFF_RP1)[r0], pb0 = WS_PTR(const int, OFF_RP0)[r0 + 1], pb1 = WS_PTR(const int, OFF_RP1)[r0 + 1];
            add_moe_rows(P, layer - 1, r0, __builtin_amdgcn_readfirstlane(pa0), __builtin_amdgcn_readfirstlane(pa1), lane, xv[0]);
            add_moe_rows(P, layer - 1, r0 + 1, __builtin_amdgcn_readfirstlane(pb0), __builtin_amdgcn_readfirstlane(pb1), lane, xv[1]);
        }
        const float* md = WS_PTR(const float, OFF_MOD) + ((size_t)layer * 17 + mod_row(r0)) * 12288;
#pragma unroll
        for (int u = 0; u < 2; ++u) { const int row = r0 + u;
            if (layer > 0) {
#pragma unroll
                for (int j = 0; j < 8; ++j) { u32x2 w; w.x = pk2(xv[u][j][0], xv[u][j][1]); w.y = pk2(xv[u][j][2], xv[u][j][3]); *(u32x2*)(X + (size_t)row * DM + 4 * lane + 256 * j) = w; } }
            const float rstd = row_rstd(xv[u], lane);
#pragma unroll
            for (int j = 0; j < 8; ++j) { const int col = 4 * lane + 256 * j; const f32x4 g = *(const f32x4*)(gmix + col), sh = *(const f32x4*)(md + col), scl = *(const f32x4*)(md + 2048 + col);
                const f32x4 h = (xv[u][j] * rstd * g) * (scl + 1.0f) + sh;
                u32x2 w; w.x = pk2(h[0], h[1]); w.y = pk2(h[2], h[3]); *(u32x2*)(HB + (size_t)row * DM + col) = w; } }
    }
}

struct RCand { float v, s; int i; };
__device__ __forceinline__ RCand rsel(bool c, const RCand& x, const RCand& y) { RCand r; r.v = c ? x.v : y.v; r.s = c ? x.s : y.s; r.i = c ? x.i : y.i; return r; }
__device__ __forceinline__ void route_select(const float (&s)[16], const float (&bz)[16], int& e0, int& e1, float& w0, float& w1) {
    RCand bt, bs; float bg = 0.f;
#pragma unroll
    for (int g = 0; g < 4; ++g) {
        const RCand ca{bz[4 * g], s[4 * g], 4 * g}, cb{bz[4 * g + 1], s[4 * g + 1], 4 * g + 1}, cc{bz[4 * g + 2], s[4 * g + 2], 4 * g + 2}, cd{bz[4 * g + 3], s[4 * g + 3], 4 * g + 3};
        const bool b01 = cb.v > ca.v, b23 = cd.v > cc.v;
        const RCand m01 = rsel(b01, cb, ca), o01 = rsel(b01, ca, cb), m23 = rsel(b23, cd, cc), o23 = rsel(b23, cc, cd);
        const bool t23 = m23.v > m01.v;
        const RCand top = rsel(t23, m23, m01);
        const RCand sec01 = rsel(m23.v > o01.v, m23, o01);
        const RCand sec23 = rsel(o23.v > m01.v, o23, m01);
        const RCand sec = rsel(t23, sec23, sec01);
        const float gsc = top.v + sec.v;
        const bool better = (g == 0) || (gsc > bg);
        if (g == 0) { bt = top; bs = sec; bg = gsc; } else { bt = rsel(better, top, bt); bs = rsel(better, sec, bs); bg = better ? gsc : bg; }
    }
    const float inv = 1.0f / (bt.s + bs.s);
    e0 = bt.i; e1 = bs.i; w0 = bt.s * inv; w1 = bs.s * inv;
}
__device__ __forceinline__ void phase_norm2(const Params& P, int layer, int nch, int cr, LAS unsigned char* lds, int bid, int nblk, int wv) {
    const int tid = tid_(wv), lane = tid & 63, wave = __builtin_amdgcn_readfirstlane(tid >> 6);
    const bf16_t* X = WS_PTR(const bf16_t, OFF_X); bf16_t* HB = WS_PTR(bf16_t, OFF_HB);
    const float* gffn = P.norm_ffn_g + layer * DM;
    LAS f32x4* WL = (LAS f32x4*)lds;
    LAS int* cnt = (LAS int*)(lds + 131072);
    int* RE0 = WS_PTR(int, OFF_RE0); int* RE1 = WS_PTR(int, OFF_RE1); float* RW0 = WS_PTR(float, OFF_RW0); float* RW1 = WS_PTR(float, OFF_RW1);
    __syncthreads();
    for (int idx = tid; idx < 8192; idx += 512) { const int col = idx >> 2, eq = idx & 3; WL[eq * 2048 + (col & 3) * 512 + (col >> 2)] = *(const f32x4*)(P.router_w + (size_t)col * 16 + eq * 4); }
    const float rbias_l = P.router_bias[((((lane >> 4) & 1) << 3) | (((lane >> 3) & 1) << 2) | (((lane >> 2) & 1) << 1) | ((lane >> 1) & 1))];
    for (int ci = bid; ci < nch; ci += nblk) {
        __syncthreads();
        if (tid < 16) cnt[tid] = 0;
        __syncthreads();
        const int rpw = cr >> 3;
        const int npair = rpw >> 1;
        u32x2 ra[8], rb[8];
        { const bf16_t* xr = X + (size_t)(ci * cr + wave * rpw) * DM + 4 * lane;
#pragma unroll
          for (int j = 0; j < 8; ++j) { ra[j] = *(const u32x2*)(xr + 256 * j); rb[j] = *(const u32x2*)(xr + DM + 256 * j); } }
        for (int rr = 0; rr < npair; ++rr) {
            const int rowA = ci * cr + wave * rpw + 2 * rr, rowB = rowA + 1;
            f32x4 ha[8], hb[8];
#pragma unroll
            for (int j = 0; j < 8; ++j) { ha[j] = (f32x4){bflo(ra[j].x), bfhi(ra[j].x), bflo(ra[j].y), bfhi(ra[j].y)}; hb[j] = (f32x4){bflo(rb[j].x), bfhi(rb[j].x), bflo(rb[j].y), bfhi(rb[j].y)}; }
            const float rstdA = row_rstd(ha, lane), rstdB = row_rstd(hb, lane);
            const float* md = WS_PTR(const float, OFF_MOD) + ((size_t)layer * 17 + mod_row(rowA)) * 12288;
#pragma unroll
            for (int j = 0; j < 8; ++j) { const int col = 4 * lane + 256 * j; const f32x4 g = *(const f32x4*)(gffn + col), sh = *(const f32x4*)(md + 3 * 2048 + col), scl = *(const f32x4*)(md + 4 * 2048 + col);
                ha[j] = (ha[j] * rstdA * g) * (scl + 1.0f) + sh; hb[j] = (hb[j] * rstdB * g) * (scl + 1.0f) + sh;
                u32x2 wa; wa.x = pk2(ha[j][0], ha[j][1]); wa.y = pk2(ha[j][2], ha[j][3]); *(u32x2*)(HB + (size_t)rowA * DM + col) = wa;
                u32x2 wb; wb.x = pk2(hb[j][0], hb[j][1]); wb.y = pk2(hb[j][2], hb[j][3]); *(u32x2*)(HB + (size_t)rowB * DM + col) = wb; }
            { const int rn = rr + 1 < npair ? rowA + 2 : rowA;
              const bf16_t* xr = X + (size_t)rn * DM + 4 * lane;
#pragma unroll
              for (int j = 0; j < 8; ++j) { ra[j] = *(const u32x2*)(xr + 256 * j); rb[j] = *(const u32x2*)(xr + DM + 256 * j); } }
            f32x2 va[8], vb[8];
#pragma unroll
            for (int e = 0; e < 8; ++e) { va[e] = (f32x2){0.f, 0.f}; vb[e] = (f32x2){0.f, 0.f}; }
            f32x4 wq[4], wn[4];
#pragma unroll
            for (int eq = 0; eq < 4; ++eq) wq[eq] = WL[eq * 2048 + lane];
#pragma unroll
            for (int jq = 0; jq < 32; ++jq) { const int j = jq >> 2, q = jq & 3;
                if (jq + 1 < 32) { const int posn = ((jq + 1) & 3) * 512 + lane + 64 * ((jq + 1) >> 2);
#pragma unroll
                    for (int eq = 0; eq < 4; ++eq) wn[eq] = WL[eq * 2048 + posn]; }
                const f32x2 xa = (f32x2){ha[j][q], ha[j][q]}, xb = (f32x2){hb[j][q], hb[j][q]};
#pragma unroll
                for (int eq = 0; eq < 4; ++eq) { const f32x2 wlo = (f32x2){wq[eq][0], wq[eq][1]}, whi = (f32x2){wq[eq][2], wq[eq][3]};
                    va[2 * eq] += xa * wlo; va[2 * eq + 1] += xa * whi; vb[2 * eq] += xb * wlo; vb[2 * eq + 1] += xb * whi; }
#pragma unroll
                for (int eq = 0; eq < 4; ++eq) wq[eq] = wn[eq];
            }
            float v[32];
#pragma unroll
            for (int e = 0; e < 8; ++e) { v[2 * e] = va[e][0]; v[2 * e + 1] = va[e][1]; v[16 + 2 * e] = vb[e][0]; v[16 + 2 * e + 1] = vb[e][1]; }
#pragma unroll
            for (int st = 0; st < 5; ++st) { const int msk = 32 >> st, half = 16 >> st; const bool up = (lane & msk) != 0;
#pragma unroll
                for (int i = 0; i < half; ++i) { float lo = v[i], hi = v[i + half]; asm volatile("" : "+v"(lo), "+v"(hi));
                    const float keep = up ? hi : lo, send = up ? lo : hi; v[i] = keep + shx(send, msk, lane); } }
            v[0] += shx(v[0], 1, lane);
            const float mys = 1.0f / (1.0f + expf(-v[0])), mybz = mys + rbias_l;
            int e0, e1; float w0, w1;
            { float sA[16], zA[16];
#pragma unroll
              for (int i = 0; i < 16; ++i) { const int src = (((i >> 3) & 1) << 4) | (((i >> 2) & 1) << 3) | (((i >> 1) & 1) << 2) | ((i & 1) << 1); sA[i] = rdlane(mys, src); zA[i] = rdlane(mybz, src); }
              route_select(sA, zA, e0, e1, w0, w1); }
            if (lane == 0) { RE0[rowA] = e0; RE1[rowA] = e1; RW0[rowA] = w0; RW1[rowA] = w1; atomicAdd((int*)(cnt + e0), 1); atomicAdd((int*)(cnt + e1), 1); }
            { float sB[16], zB[16];
#pragma unroll
              for (int i = 0; i < 16; ++i) { const int src = 32 | (((i >> 3) & 1) << 4) | (((i >> 2) & 1) << 3) | (((i >> 1) & 1) << 2) | ((i & 1) << 1); sB[i] = rdlane(mys, src); zB[i] = rdlane(mybz, src); }
              route_select(sB, zB, e0, e1, w0, w1); }
            if (lane == 0) { RE0[rowB] = e0; RE1[rowB] = e1; RW0[rowB] = w0; RW1[rowB] = w1; atomicAdd((int*)(cnt + e0), 1); atomicAdd((int*)(cnt + e1), 1); }
        }
        __syncthreads();
        if (tid < 16) WS_PTR(int, OFF_BLKCNT)[ci * 16 + tid] = cnt[tid];
    }
    __syncthreads();
}

__device__ __forceinline__ void phase_route2(const Params& P, int nch, int cr, LAS unsigned char* lds, int bid, int nblk, int wv) {
    const int tid = tid_(wv);
    LAS int* sT = (LAS int*)lds;
    LAS int* sP = sT + 512;
    LAS int* sTot = sP + 512;
    LAS int* sPre = sTot + 16;
    LAS int* sSeg = sPre + 16;
    LAS int* sE0 = sSeg + 32;
    LAS int* sE1 = sE0 + 160;
    const int* BC = WS_PTR(const int, OFF_BLKCNT);
    int* ST = WS_PTR(int, OFF_SORTTOK); float* SG = WS_PTR(float, OFF_SORTGATE); int* TL = WS_PTR(int, OFF_TILE);
    for (int ci = bid; ci < nch; ci += nblk) {
        __syncthreads();
        { const int e = tid & 15, j = tid >> 4; int tot = 0, pre = 0;
          for (int c2 = j; c2 < nch; c2 += 32) { const int v = BC[c2 * 16 + e]; tot += v; if (c2 < ci) pre += v; }
          sT[j * 16 + e] = tot; sP[j * 16 + e] = pre; }
        __syncthreads();
        if (tid < 16) { int t = 0, p = 0; for (int j = 0; j < 32; ++j) { t += sT[j * 16 + tid]; p += sP[j * 16 + tid]; } sTot[tid] = t; sPre[tid] = p; }
        __syncthreads();
        if (tid == 0) { int off = 0; for (int e = 0; e < 16; ++e) { sSeg[e] = off; off += ((sTot[e] + 255) >> 8) << 8; } sSeg[16] = off; }
        if (tid < cr) { const int tok = ci * cr + tid; sE0[tid] = WS_PTR(const int, OFF_RE0)[tok]; sE1[tid] = WS_PTR(const int, OFF_RE1)[tok]; }
        __syncthreads();
        if (tid < cr) { const int tok = ci * cr + tid; const int e0 = sE0[tid], e1 = sE1[tid]; int r0 = 0, r1 = 0;
            for (int t2 = 0; t2 < tid; ++t2) { const int a = sE0[t2], b = sE1[t2]; r0 += (a == e0) + (b == e0); r1 += (a == e1) + (b == e1); }
            const int p0 = sSeg[e0] + sPre[e0] + r0, p1 = sSeg[e1] + sPre[e1] + r1;
            WS_PTR(int, OFF_RP0)[tok] = p0; WS_PTR(int, OFF_RP1)[tok] = p1;
            ST[p0] = tok; ST[p1] = tok; SG[p0] = WS_PTR(const float, OFF_RW0)[tok]; SG[p1] = WS_PTR(const float, OFF_RW1)[tok]; }
        if (ci == 0) {
            for (int e = 0; e < 16; ++e) { const int s0 = sSeg[e], s1 = sSeg[e + 1];
                for (int t = (s0 >> 8) + tid; t < (s1 >> 8); t += 512) TL[t] = e;
                for (int p = s0 + sTot[e] + tid; p < s1; p += 512) { ST[p] = -1; SG[p] = 0.f; } }
            if (tid == 0) TL[511] = sSeg[16] >> 8;
        }
    }
    __syncthreads();
}

__device__ __forceinline__ void phase_gather(const Params& P, int bid, int nblk, int wv) {
    const int tid = tid_(wv), lane = tid & 63, wave = __builtin_amdgcn_readfirstlane(tid >> 6);
    const int nrows = WS_PTR(const int, OFF_TILE)[511] * 256;
    const bf16_t* HB = WS_PTR(const bf16_t, OFF_HB); bf16_t* AS = WS_PTR(bf16_t, OFF_YBUF); const int* ST = WS_PTR(const int, OFF_SORTTOK);
    for (int p0 = 4 * (bid * 8 + wave); p0 < nrows; p0 += nblk * 32) {
        int tok[4];
#pragma unroll
        for (int u = 0; u < 4; ++u) tok[u] = ST[p0 + u];
        u32x4 v[4][4];
#pragma unroll
        for (int u = 0; u < 4; ++u)
#pragma unroll
            for (int j = 0; j < 4; ++j) v[u][j] = *(const u32x4*)(HB + (size_t)(tok[u] < 0 ? 0 : tok[u]) * DM + 8 * lane + 512 * j);
#pragma unroll
        for (int u = 0; u < 4; ++u)
#pragma unroll
            for (int j = 0; j < 4; ++j) *(u32x4*)(AS + (size_t)(p0 + u) * DM + 8 * lane + 512 * j) = tok[u] >= 0 ? v[u][j] : (u32x4){0u, 0u, 0u, 0u};
    }
}

__device__ __forceinline__ void ld8(const bf16_t* p, float (&o)[8]) { const u32x4 w = *(const u32x4*)p; o[0] = bflo(w.x); o[1] = bfhi(w.x); o[2] = bflo(w.y); o[3] = bfhi(w.y); o[4] = bflo(w.z); o[5] = bfhi(w.z); o[6] = bflo(w.w); o[7] = bfhi(w.w); }
__device__ __forceinline__ void st8(bf16_t* p, const float (&o)[8]) { u32x4 w; w.x = pk2(o[0], o[1]); w.y = pk2(o[2], o[3]); w.z = pk2(o[4], o[5]); w.w = pk2(o[6], o[7]); *(u32x4*)p = w; }
__device__ __forceinline__ void phase_finalize_s5(const Params& P, int layer, int nrows, int bid, int nblk, int wv) {
    const int tid = tid_(wv), lane = tid & 63, wave = __builtin_amdgcn_readfirstlane(tid >> 6);
    const bf16_t* HB = WS_PTR(const bf16_t, OFF_HB); const bf16_t* PB = WS_PTR(const bf16_t, OFF_PB); const bf16_t* PP = WS_PTR(const bf16_t, OFF_P); bf16_t* GY = WS_PTR(bf16_t, OFF_GY);
    const int c8 = 8 * lane;
    float dd[8];
#pragma unroll
    for (int q = 0; q < 8; ++q) dd[q] = P.s5_d[layer * 512 + c8 + q];
    for (int r0 = 4 * (bid * 8 + wave); r0 < nrows; r0 += nblk * 32) {
        u32x4 fa[4], fb[4], fg[4];
#pragma unroll
        for (int u = 0; u < 4; ++u) { const int row = r0 + u; fa[u] = *(const u32x4*)(HB + (size_t)row * DM + c8); fb[u] = *(const u32x4*)(PB + (size_t)row * DM + c8); fg[u] = *(const u32x4*)(PP + p_off(row, c8)); }
#pragma unroll
        for (int u = 0; u < 4; ++u) { float a[8], b[8], g[8], o[8];
#define UNPK(W_, A_) do { A_[0] = bflo(W_.x); A_[1] = bfhi(W_.x); A_[2] = bflo(W_.y); A_[3] = bfhi(W_.y); A_[4] = bflo(W_.z); A_[5] = bfhi(W_.z); A_[6] = bflo(W_.w); A_[7] = bfhi(W_.w); } while (0)
            UNPK(fa[u], a); UNPK(fb[u], b); UNPK(fg[u], g);
#pragma unroll
            for (int q = 0; q < 8; ++q) o[q] = geluf_(dd[q] * g[q] + a[q] + b[q]);
            st8(GY + (size_t)(r0 + u) * 512 + c8, o); }
    }
}
__device__ __forceinline__ void phase_finalize_rest(const Params& P, int layer, int nrows, int bid, int nblk, int wv) {
    const int tid = tid_(wv), lane = tid & 63, wave = __builtin_amdgcn_readfirstlane(tid >> 6);
    bf16_t* HB = WS_PTR(bf16_t, OFF_HB); const bf16_t* PB = WS_PTR(const bf16_t, OFF_PB); const bf16_t* PP = WS_PTR(const bf16_t, OFF_P);
    const int c8 = 8 * lane;
    for (int row = bid * 8 + wave; row < nrows; row += nblk * 8) {
        bf16_t* hb = HB + (size_t)row * DM; const bf16_t* pb = PB + (size_t)row * DM;
        u32x4 fa[4], fb[4], fg[4];
#pragma unroll
        for (int sct = 1; sct < 4; ++sct) { fa[sct] = *(const u32x4*)(hb + sct * 512 + c8); fb[sct] = *(const u32x4*)(pb + sct * 512 + c8); }
        fg[1] = *(const u32x4*)(PP + p_off(row, 2 * 512 + c8)); fg[2] = *(const u32x4*)(PP + p_off(row, 7 * 512 + c8)); fg[3] = *(const u32x4*)(PP + p_off(row, 11 * 512 + c8));
        float a[8], b[8], g[8], o[8];
        UNPK(fa[1], a); UNPK(fb[1], b); UNPK(fg[1], g);
#pragma unroll
        for (int q = 0; q < 8; ++q) o[q] = (a[q] + b[q]) * geluf_(g[q]);
        st8(hb + 512 + c8, o);
#pragma unroll
        for (int mx = 0; mx < 2; ++mx) {
            UNPK(fa[2 + mx], a); UNPK(fb[2 + mx], b); UNPK(fg[2 + mx], g);
            float ss = 0.f;
#pragma unroll
            for (int q = 0; q < 8; ++q) { a[q] += b[q]; ss += a[q] * a[q]; }
            ss += shx(ss, 1, lane); ss += shx(ss, 2, lane); ss += shx(ss, 4, lane); ss += shx(ss, 8, lane);
            const float rs = rsqrtf(ss * (1.0f / 128.0f) + EPS);
#pragma unroll
            for (int q = 0; q < 8; ++q) o[q] = a[q] * rs * siluf_(g[q]);
            st8(hb + 1024 + mx * 512 + c8, o);
        }
#undef UNPK
    }
}
__device__ __forceinline__ void phase_finalize(const Params& P, int layer, int nrows, int bid, int nblk, int wv) {
    const int tid = tid_(wv), lane = tid & 63, wave = __builtin_amdgcn_readfirstlane(tid >> 6);
    bf16_t* HB = WS_PTR(bf16_t, OFF_HB); const bf16_t* PB = WS_PTR(const bf16_t, OFF_PB); const bf16_t* PP = WS_PTR(const bf16_t, OFF_P); bf16_t* GY = WS_PTR(bf16_t, OFF_GY);
    const int c8 = 8 * lane;
    float dd[8];
#pragma unroll
    for (int q = 0; q < 8; ++q) dd[q] = P.s5_d[layer * 512 + c8 + q];
    for (int row = bid * 8 + wave; row < nrows; row += nblk * 8) {
        bf16_t* hb = HB + (size_t)row * DM; const bf16_t* pb = PB + (size_t)row * DM;
        u32x4 fa[4], fb[4], fg[4];
#pragma unroll
        for (int sct = 0; sct < 4; ++sct) { fa[sct] = *(const u32x4*)(hb + sct * 512 + c8); fb[sct] = *(const u32x4*)(pb + sct * 512 + c8); }
        fg[0] = *(const u32x4*)(PP + p_off(row, 0 * 512 + c8)); fg[1] = *(const u32x4*)(PP + p_off(row, 2 * 512 + c8)); fg[2] = *(const u32x4*)(PP + p_off(row, 7 * 512 + c8)); fg[3] = *(const u32x4*)(PP + p_off(row, 11 * 512 + c8));
        float a[8], b[8], g[8], o[8];
#define UNPK(W_, A_) do { A_[0] = bflo(W_.x); A_[1] = bfhi(W_.x); A_[2] = bflo(W_.y); A_[3] = bfhi(W_.y); A_[4] = bflo(W_.z); A_[5] = bfhi(W_.z); A_[6] = bflo(W_.w); A_[7] = bfhi(W_.w); } while (0)
        UNPK(fa[0], a); UNPK(fb[0], b); UNPK(fg[0], g);
#pragma unroll
        for (int q = 0; q < 8; ++q) o[q] = geluf_(dd[q] * g[q] + a[q] + b[q]);
        st8(GY + (size_t)row * 512 + c8, o);
        UNPK(fa[1], a); UNPK(fb[1], b); UNPK(fg[1], g);
#pragma unroll
        for (int q = 0; q < 8; ++q) o[q] = (a[q] + b[q]) * geluf_(g[q]);
        st8(hb + 512 + c8, o);
#pragma unroll
        for (int mx = 0; mx < 2; ++mx) {
            UNPK(fa[2 + mx], a); UNPK(fb[2 + mx], b); UNPK(fg[2 + mx], g);
            float ss = 0.f;
#pragma unroll
            for (int q = 0; q < 8; ++q) { a[q] += b[q]; ss += a[q] * a[q]; }
            ss += shx(ss, 1, lane); ss += shx(ss, 2, lane); ss += shx(ss, 4, lane); ss += shx(ss, 8, lane);
            const float rs = rsqrtf(ss * (1.0f / 128.0f) + EPS);
#pragma unroll
            for (int q = 0; q < 8; ++q) o[q] = a[q] * rs * siluf_(g[q]);
            st8(hb + 1024 + mx * 512 + c8, o);
        }
#undef UNPK
    }
}

__device__ __forceinline__ void phase_final(const Params& P, int bid, int nblk, int wv) {
    const int tid = tid_(wv), lane = tid & 63, wave = __builtin_amdgcn_readfirstlane(tid >> 6);
    const bf16_t* X = WS_PTR(const bf16_t, OFF_X); const bf16_t* YB = WS_PTR(const bf16_t, OFF_YBUF);
    const int* RP0 = WS_PTR(const int, OFF_RP0); const int* RP1 = WS_PTR(const int, OFF_RP1);
    const int step = nblk * 8;
    int row = bid * 8 + wave;
    if (row >= NLAT) return;
    auto clampr = [&](int r) { return r < NLAT ? r : row; };
    f32x4 fg[8];
#pragma unroll
    for (int j = 0; j < 8; ++j) fg[j] = *(const f32x4*)(P.final_g + 4 * lane + 256 * j);
    u32x2 cx[8], ca[8], cb[8];
    { const int q0 = __builtin_amdgcn_readfirstlane(RP0[row]), q1 = __builtin_amdgcn_readfirstlane(RP1[row]);
      const bf16_t* xr = X + (size_t)row * DM + 4 * lane; const bf16_t* y0 = YB + (size_t)q0 * DM + 4 * lane; const bf16_t* y1 = YB + (size_t)q1 * DM + 4 * lane;
#pragma unroll
      for (int j = 0; j < 8; ++j) { cx[j] = *(const u32x2*)(xr + 256 * j); ca[j] = *(const u32x2*)(y0 + 256 * j); cb[j] = *(const u32x2*)(y1 + 256 * j); } }
    int pn0 = RP0[clampr(row + step)], pn1 = RP1[clampr(row + step)];
    for (; row < NLAT; row += step) {
        const int nrow = clampr(row + step), n2 = clampr(row + 2 * step);
        const int q0 = __builtin_amdgcn_readfirstlane(pn0), q1 = __builtin_amdgcn_readfirstlane(pn1);
        pn0 = RP0[n2]; pn1 = RP1[n2];
        const float* g5 = WS_PTR(const float, OFF_MOD) + ((size_t)1 * 17 + mod_row(row)) * 12288 + 5 * 2048;
        f32x4 xv[8];
#pragma unroll
        for (int j = 0; j < 8; ++j) { const f32x4 g = *(const f32x4*)(g5 + 4 * lane + 256 * j);
            xv[j][0] = bflo(cx[j].x) + g[0] * (bflo(ca[j].x) + bflo(cb[j].x)); xv[j][1] = bfhi(cx[j].x) + g[1] * (bfhi(ca[j].x) + bfhi(cb[j].x));
            xv[j][2] = bflo(cx[j].y) + g[2] * (bflo(ca[j].y) + bflo(cb[j].y)); xv[j][3] = bfhi(cx[j].y) + g[3] * (bfhi(ca[j].y) + bfhi(cb[j].y)); }
        { const bf16_t* xr = X + (size_t)nrow * DM + 4 * lane; const bf16_t* y0 = YB + (size_t)q0 * DM + 4 * lane; const bf16_t* y1 = YB + (size_t)q1 * DM + 4 * lane;
#pragma unroll
          for (int j = 0; j < 8; ++j) { cx[j] = *(const u32x2*)(xr + 256 * j); ca[j] = *(const u32x2*)(y0 + 256 * j); cb[j] = *(const u32x2*)(y1 + 256 * j); } }
        const float rstd = row_rstd(xv, lane);
#pragma unroll
        for (int j = 0; j < 8; ++j) *(f32x4*)(P.out + (size_t)row * DM + 4 * lane + 256 * j) = xv[j] * rstd * fg[j];
    }
}
typedef short bf16x8 __attribute__((ext_vector_type(8)));
typedef float f32x16 __attribute__((ext_vector_type(16)));
constexpr int G_RS = 272, G_TS = 144;
constexpr int G_QS = 0, G_KS = G_QS + 64 * G_RS, G_QH = G_KS + 64 * G_RS, G_KT = G_QH + 64 * G_RS, G_VT = G_KT + 128 * G_TS, G_ST = G_VT + 128 * G_TS,
              G_TOT = G_ST + 128 * G_RS, G_EXPL = G_TOT + 8 * 128 * 4, G_END = G_EXPL + 512;
static_assert(G_END <= 147456 - 64, "GLA LDS");
__device__ __forceinline__ bf16x8 ldsfrag(const LAS unsigned char* p) { return *(const LAS bf16x8*)p; }
typedef __bf16 bf16x2_t __attribute__((ext_vector_type(2)));
__device__ __forceinline__ unsigned pkbf(float lo, float hi) { const f32x2 v = {lo, hi}; return __builtin_bit_cast(unsigned, __builtin_convertvector(v, bf16x2_t)); }
__device__ __forceinline__ bf16x8 pack8(float a0, float a1, float a2, float a3, float a4, float a5, float a6, float a7) {
    u32x4 w; w.x = pkbf(a0, a1); w.y = pkbf(a2, a3); w.z = pkbf(a4, a5); w.w = pkbf(a6, a7); return __builtin_bit_cast(bf16x8, w);
}
#define MFMA32(a, b, c) __builtin_amdgcn_mfma_f32_32x32x16_bf16((a), (b), (c), 0, 0, 0)

__device__ __forceinline__ void phase_gla_chunk(const Params& P, int layer, LAS unsigned char* lds, int bid, int nblk, int wv) {
    for (int unit = bid; unit < 256; unit += nblk) {
        const int tid = tid_(wv), lane = tid & 63, w = __builtin_amdgcn_readfirstlane(tid >> 6);
        const int r32 = lane & 31, hh = lane >> 5, th = w >> 2, dq = w & 3;
        const int d0 = 2 * lane;
        const bf16_t* PP = WS_PTR(const bf16_t, OFF_P);
        const int dir = unit & 1, head = (unit >> 1) & 3, b = (unit >> 3) & 15, mx = unit >> 7;
        const int cq = ((mx ? 8 : 3) * 4 + head) * (NTOK * PBLK) + d0, ck = ((mx ? 9 : 4 + dir) * 4 + head) * (NTOK * PBLK) + d0, cv = ((mx ? 10 : 6) * 4 + head) * (NTOK * PBLK) + d0;
        bf16_t* dst = (dir ? WS_PTR(bf16_t, OFF_PB) : WS_PTR(bf16_t, OFF_HB)) + 1024 + mx * 512 + head * 128;
        const f32x2 lb01 = *(const f32x2*)(WS_PTR(const float, OFF_LB) + ((layer * 2 + dir) * 512 + head * 128) + (unsigned)d0);
        const float lb0 = lb01[0], lb1 = lb01[1];
        const float lfret = log1pf(-exp2f(-((dir ? 5.5f : 5.0f) + (float)head)));
        const float qscale = 0.08838834764831845f;
        f32x16 accS[2];
#pragma unroll
        for (int i = 0; i < 16; ++i) { accS[0][i] = 0.f; accS[1][i] = 0.f; }
        __syncthreads();
        unsigned rq[8], rk[8], rv[8];
        const long rstep = dir ? -(long)PBLK : (long)PBLK;
        auto fetch = [&](int c) {
            const bf16_t* pr = PP + (size_t)scan_row(b, dir, 64 * c + 8 * w) * PBLK;
#pragma unroll
            for (int i = 0; i < 8; ++i) { rq[i] = *(const unsigned*)(pr + cq); rk[i] = *(const unsigned*)(pr + ck); rv[i] = *(const unsigned*)(pr + cv); pr += rstep; }
        };
        fetch(0);
        float q0[8], q1[8], k0[8], k1[8], v0[8], v1[8], tot0 = 0.f, tot1 = 0.f;
        auto elem = [&](int c) {
            if (mx == 0) {
                float p0 = 1.0f, p1 = 1.0f;
#pragma unroll
                for (int i = 0; i < 8; ++i) {
                    q0[i] = bflo(rq[i]) * qscale; q1[i] = bfhi(rq[i]) * qscale;
                    const float sg0 = sigmoidf_(bflo(rk[i])), sg1 = sigmoidf_(bfhi(rk[i]));
                    const float f0 = lb0 + (1.0f - lb0) * sg0, f1 = lb1 + (1.0f - lb1) * sg1;
                    k0[i] = (1.0f - lb0) * (1.0f - sg0); k1[i] = (1.0f - lb1) * (1.0f - sg1);
                    p0 *= f0; p1 *= f1;
                    v0[i] = bflo(rv[i]); v1[i] = bfhi(rv[i]);
                }
                tot0 = __logf(p0); tot1 = __logf(p1);
            } else {
                const bool lat = c >= 4;
                if (!lat) {
#pragma unroll
                    for (int i = 0; i < 8; ++i) { q0[i] = bflo(rq[i]); q1[i] = bfhi(rq[i]); k0[i] = bflo(rk[i]) * qscale; k1[i] = bfhi(rk[i]) * qscale;
                        v0[i] = bflo(rv[i]); v1[i] = bfhi(rv[i]); }
                } else {
                    const int m = c - 4;
                    const float rowpos = (float)(dir ? 31 - m : m);
                    int dl = d0; asm volatile("" : "+v"(dl));
                    const bool isrow = (dl & 63) < 32;
                    const float sg = dl < 64 ? -1.0f : 1.0f;
                    const float invf0 = exp2f(-(float)(dl & 31) * (13.287712379549449f / 32.0f)), invf1 = exp2f(-(float)((dl + 1) & 31) * (13.287712379549449f / 32.0f));
                    const float pos0 = isrow ? rowpos : (float)(dir ? 63 - 8 * w : 8 * w);
                    float cc0 = __cosf(pos0 * invf0), ss0 = sg * __sinf(pos0 * invf0), cc1 = __cosf(pos0 * invf1), ss1 = sg * __sinf(pos0 * invf1);
                    const float st = isrow ? 0.0f : (dir ? -1.0f : 1.0f);
                    const float rtc0 = __cosf(st * invf0), rts0 = sg * __sinf(st * invf0), rtc1 = __cosf(st * invf1), rts1 = sg * __sinf(st * invf1);
#pragma unroll
                    for (int i = 0; i < 8; ++i) {
                        const float a0 = bflo(rq[i]), a1 = bfhi(rq[i]), e0 = bflo(rk[i]), e1 = bfhi(rk[i]);
                        const float pa0 = shx(a0, 32, lane), pa1 = shx(a1, 32, lane), pe0 = shx(e0, 32, lane), pe1 = shx(e1, 32, lane);
                        q0[i] = a0 * cc0 + pa0 * ss0; q1[i] = a1 * cc1 + pa1 * ss1;
                        k0[i] = (e0 * cc0 + pe0 * ss0) * qscale; k1[i] = (e1 * cc1 + pe1 * ss1) * qscale;
                        v0[i] = bflo(rv[i]); v1[i] = bfhi(rv[i]);
                        if (i < 7) { const float n0 = cc0 * rtc0 - ss0 * rts0, n1 = cc1 * rtc1 - ss1 * rts1; ss0 = ss0 * rtc0 + cc0 * rts0; ss1 = ss1 * rtc1 + cc1 * rts1; cc0 = n0; cc1 = n1; }
                    }
                }
            }
            if (mx) { tot0 = 8.0f * lfret; tot1 = tot0; }
        };
        elem(0);
        fetch(1);
        for (int c = 0; c < SCAN / 64; ++c) {
            *(LAS f32x2*)(lds + G_TOT + (w * 128 + d0) * 4) = (f32x2){tot0, tot1};
            __syncthreads();
            float pre0 = 0.f, pre1 = 0.f, mid0 = 0.f, mid1 = 0.f, las0 = 0.f, las1 = 0.f;
#pragma unroll
            for (int g = 0; g < 8; ++g) { const f32x2 tt = *(const LAS f32x2*)(lds + G_TOT + (g * 128 + d0) * 4);
                if (g < w) { pre0 += tt[0]; pre1 += tt[1]; } if (g < 4) { mid0 += tt[0]; mid1 += tt[1]; } las0 += tt[0]; las1 += tt[1]; }
            const float em0 = __expf(mid0), em1 = __expf(mid1), el0 = __expf(las0 - mid0), el1 = __expf(las1 - mid1);
            if (w == 0) *(LAS f32x2*)(lds + G_EXPL + d0 * 4) = (f32x2){__expf(las0), __expf(las1)};
            float kh0[8], kh1[8];
            auto a2q = [&](int i, float ea0, float ea1) {
                const float qt0 = q0[i] * ea0, qt1 = q1[i] * ea1; const int t = 8 * w + i;
                *(LAS unsigned*)(lds + G_QS + t * G_RS + d0 * 2) = pkbf(qt0, qt1);
                *(LAS unsigned*)(lds + G_QH + t * G_RS + d0 * 2) = pkbf(qt0 * em0, qt1 * em1);
            };
            auto a2k = [&](int i, float eb0, float eb1) {
                const float kt0 = k0[i] * eb0, kt1 = k1[i] * eb1; const int t = 8 * w + i;
                *(LAS unsigned*)(lds + G_KS + t * G_RS + d0 * 2) = pkbf(kt0, kt1);
                kh0[i] = kt0 * el0; kh1[i] = kt1 * el1;
            };
            if (mx) {
                const float xf = pre0 + lfret - mid0; float rea = __expf(xf), reb = __expf(-xf);
                const float fdec = __expf(lfret), finv = __expf(-lfret);
#pragma unroll
                for (int i = 0; i < 8; ++i) { a2q(i, rea, rea); a2k(i, reb, reb); rea *= fdec; reb *= finv; }
            } else {
                float p0 = __expf(pre0 - mid0), p1 = __expf(pre1 - mid1);
#pragma unroll
                for (int i = 0; i < 8; ++i) { p0 *= 1.0f - k0[i]; p1 *= 1.0f - k1[i]; a2q(i, p0, p1); }
                float s0 = __expf(mid0 - pre0 - tot0), s1 = __expf(mid1 - pre1 - tot1);
#pragma unroll
                for (int i = 7; i >= 0; --i) { a2k(i, s0, s1); s0 *= 1.0f - k0[i]; s1 *= 1.0f - k1[i]; }
            }
            {
                const int p0 = 16 * (w >> 1) + ((w & 1) ? 4 : 0), p1 = 16 * (w >> 1) + ((w & 1) ? 12 : 8);
                *(LAS u32x2*)(lds + G_KT + d0 * G_TS + p0 * 2) = (u32x2){pkbf(kh0[0], kh0[1]), pkbf(kh0[2], kh0[3])};
                *(LAS u32x2*)(lds + G_KT + d0 * G_TS + p1 * 2) = (u32x2){pkbf(kh0[4], kh0[5]), pkbf(kh0[6], kh0[7])};
                *(LAS u32x2*)(lds + G_KT + (d0 + 1) * G_TS + p0 * 2) = (u32x2){pkbf(kh1[0], kh1[1]), pkbf(kh1[2], kh1[3])};
                *(LAS u32x2*)(lds + G_KT + (d0 + 1) * G_TS + p1 * 2) = (u32x2){pkbf(kh1[4], kh1[5]), pkbf(kh1[6], kh1[7])};
                *(LAS u32x2*)(lds + G_VT + d0 * G_TS + p0 * 2) = (u32x2){pkbf(v0[0], v0[1]), pkbf(v0[2], v0[3])};
                *(LAS u32x2*)(lds + G_VT + d0 * G_TS + p1 * 2) = (u32x2){pkbf(v0[4], v0[5]), pkbf(v0[6], v0[7])};
                *(LAS u32x2*)(lds + G_VT + (d0 + 1) * G_TS + p0 * 2) = (u32x2){pkbf(v1[0], v1[1]), pkbf(v1[2], v1[3])};
                *(LAS u32x2*)(lds + G_VT + (d0 + 1) * G_TS + p1 * 2) = (u32x2){pkbf(v1[4], v1[5]), pkbf(v1[6], v1[7])};
            }
#pragma unroll
            for (int kt = 0; kt < 2; ++kt)
#pragma unroll
                for (int g4 = 0; g4 < 4; ++g4)
                    *(LAS u32x2*)(lds + G_ST + (32 * dq + r32) * G_RS + (64 * th + 32 * kt + 8 * g4 + 4 * hh) * 2) = (u32x2){pkbf(accS[kt][4 * g4], accS[kt][4 * g4 + 1]), pkbf(accS[kt][4 * g4 + 2], accS[kt][4 * g4 + 3])};
            __syncthreads();
            const int fo = 16 * hh;
            const bool need_o = !(layer == 1 && c < CTXL / 64);
            f32x16 sc0, sc1;
#pragma unroll
            for (int i = 0; i < 16; ++i) { sc0[i] = 0.f; sc1[i] = 0.f; }
            if (need_o) {
#pragma unroll
            for (int ks = 0; ks < 8; ++ks) {
                const bf16x8 bq = ldsfrag(lds + G_QS + (32 * th + r32) * G_RS + ks * 32 + fo);
                sc0 = MFMA32(ldsfrag(lds + G_KS + r32 * G_RS + ks * 32 + fo), bq, sc0);
                if (th) sc1 = MFMA32(ldsfrag(lds + G_KS + (32 + r32) * G_RS + ks * 32 + fo), bq, sc1);
            }
            }
            if (c + 1 < SCAN / 64) {
                elem(c + 1);
                if (c + 2 < SCAN / 64) fetch(c + 2);
            }
            f32x16 o;
            if (need_o) {
#pragma unroll
            for (int r = 0; r < 16; ++r) { const int s_r = (r & 3) + 8 * (r >> 2) + 4 * hh; const bool keep = s_r <= r32;
                if (th) sc1[r] = keep ? sc1[r] : 0.f; else sc0[r] = keep ? sc0[r] : 0.f; }
#pragma unroll
            for (int i = 0; i < 16; ++i) o[i] = 0.f;
#pragma unroll
            for (int k2 = 0; k2 < 2; ++k2) {
                const bf16x8 pb = pack8(sc0[8 * k2], sc0[8 * k2 + 1], sc0[8 * k2 + 2], sc0[8 * k2 + 3], sc0[8 * k2 + 4], sc0[8 * k2 + 5], sc0[8 * k2 + 6], sc0[8 * k2 + 7]);
                o = MFMA32(ldsfrag(lds + G_VT + (32 * dq + r32) * G_TS + (16 * k2) * 2 + fo), pb, o);
            }
            if (th) {
#pragma unroll
                for (int k2 = 0; k2 < 2; ++k2) {
                    const bf16x8 pb = pack8(sc1[8 * k2], sc1[8 * k2 + 1], sc1[8 * k2 + 2], sc1[8 * k2 + 3], sc1[8 * k2 + 4], sc1[8 * k2 + 5], sc1[8 * k2 + 6], sc1[8 * k2 + 7]);
                    o = MFMA32(ldsfrag(lds + G_VT + (32 * dq + r32) * G_TS + (32 + 16 * k2) * 2 + fo), pb, o);
                }
            }
#pragma unroll
            for (int ks = 0; ks < 8; ++ks)
                o = MFMA32(ldsfrag(lds + G_ST + (32 * dq + r32) * G_RS + ks * 32 + fo), ldsfrag(lds + G_QH + (32 * th + r32) * G_RS + ks * 32 + fo), o);
            }
#pragma unroll
            for (int kt = 0; kt < 2; ++kt) {
#pragma unroll
                for (int g4 = 0; g4 < 4; ++g4) { const f32x4 e4 = *(const LAS f32x4*)(lds + G_EXPL + (64 * th + 32 * kt + 8 * g4 + 4 * hh) * 4);
                    accS[kt][4 * g4] *= e4[0]; accS[kt][4 * g4 + 1] *= e4[1]; accS[kt][4 * g4 + 2] *= e4[2]; accS[kt][4 * g4 + 3] *= e4[3]; }
#pragma unroll
                for (int ks = 0; ks < 4; ++ks)
                    accS[kt] = MFMA32(ldsfrag(lds + G_KT + (64 * th + 32 * kt + r32) * G_TS + ks * 32 + fo), ldsfrag(lds + G_VT + (32 * dq + r32) * G_TS + ks * 32 + fo), accS[kt]);
            }
            if (need_o) {
                bf16_t* orow = dst + (size_t)scan_row(b, dir, 64 * c + 32 * th + r32) * DM + 32 * dq + 4 * hh;
#pragma unroll
                for (int g4 = 0; g4 < 4; ++g4) *(u32x2*)(orow + 8 * g4) = (u32x2){pkbf(o[4 * g4], o[4 * g4 + 1]), pkbf(o[4 * g4 + 2], o[4 * g4 + 3])};
            }
        }
    }
    __syncthreads();
}
typedef float f32x4_ __attribute__((ext_vector_type(4)));
#define MFMA16(a, b, c) __builtin_amdgcn_mfma_f32_16x16x32_bf16((a), (b), (c), 0, 0, 0)
__device__ __forceinline__ float swap32(float x, int hh) {
    const auto r = __builtin_amdgcn_permlane32_swap(__float_as_uint(x), __float_as_uint(x), false, false);
    return __uint_as_float(hh ? r[0] : r[1]);
}
constexpr int S5_LDS = 32 * 272;
constexpr int LRU_LDS = 32 * 144;

__device__ __forceinline__ void s5_unit(const Params& P, int layer, int b, int g, int dir, LAS unsigned char* hl, int lane) {
    const int r32 = lane & 31, hh = lane >> 5;
    const int pi = (layer * 2 + dir) * 32 + g;
    const bf16_t* PP = WS_PTR(const bf16_t, OFF_P);
    bf16_t* dst = (dir ? WS_PTR(bf16_t, OFF_PB) : WS_PTR(bf16_t, OFF_HB)) + g * 16 + 4 * (lane >> 4);
    const float dt = expf(P.s5_log_dt[pi]);
    float akr[2][4], aki[2][4];
    bf16x8 Bp[4];
#pragma unroll
    for (int s = 0; s < 2; ++s) {
        const int p = r32 + 32 * s;
        const float lr = P.s5_lam_re[pi * 64 + p], li = P.s5_lam_im[pi * 64 + p];
        const float mag = expf(lr * dt), ar = mag * cosf(li * dt), ai = mag * sinf(li * dt);
        const float den = lr * lr + li * li, zr = ar - 1.0f;
        const float wre = (zr * lr + ai * li) / den, wim = (ai * lr - zr * li) / den;
        akr[s][0] = ar; aki[s][0] = ai;
#pragma unroll
        for (int k = 1; k < 4; ++k) { akr[s][k] = akr[s][k - 1] * ar - aki[s][k - 1] * ai; aki[s][k] = akr[s][k - 1] * ai + aki[s][k - 1] * ar; }
        float vr[8], vi[8];
#pragma unroll
        for (int jj = 0; jj < 8; ++jj) { const int c = 8 * hh + jj; const float br = P.s5_b_re[((size_t)pi * 16 + c) * 64 + p], bi = P.s5_b_im[((size_t)pi * 16 + c) * 64 + p];
            vr[jj] = wre * br - wim * bi; vi[jj] = wre * bi + wim * br; }
        Bp[s] = pack8(vr[0], vr[1], vr[2], vr[3], vr[4], vr[5], vr[6], vr[7]);
        Bp[2 + s] = pack8(vi[0], vi[1], vi[2], vi[3], vi[4], vi[5], vi[6], vi[7]);
    }
    bf16x8 Cm[4];
#pragma unroll
    for (int ks = 0; ks < 4; ++ks) { float cv[8];
#pragma unroll
        for (int jj = 0; jj < 8; ++jj) { const int kp = 32 * ks + 8 * (lane >> 4) + jj, plo = kp >> 2, nt = kp & 3, p = plo + 32 * (nt & 1);
            cv[jj] = (nt >> 1) ? -P.s5_c_im[((size_t)pi * 64 + p) * 16 + (lane & 15)] : P.s5_c_re[((size_t)pi * 64 + p) * 16 + (lane & 15)]; }
        Cm[ks] = pack8(cv[0], cv[1], cv[2], cv[3], cv[4], cv[5], cv[6], cv[7]); }
    float cr[2] = {0.f, 0.f}, ci[2] = {0.f, 0.f};
    bf16x8 ua = *(const bf16x8*)(PP + p_off(scan_row(b, dir, r32), g * 16 + 8 * hh));
    for (int tile = 0; tile < SCAN / 32; ++tile) {
        const int tn = tile + 1 < SCAN / 32 ? tile + 1 : tile;
        const bf16x8 un = *(const bf16x8*)(PP + p_off(scan_row(b, dir, 32 * tn + r32), g * 16 + 8 * hh));
        f32x16 D[4];
#pragma unroll
        for (int nt = 0; nt < 4; ++nt) { f32x16 z;
#pragma unroll
            for (int i = 0; i < 16; ++i) z[i] = 0.f;
            D[nt] = MFMA32(ua, Bp[nt], z); }
#pragma unroll
        for (int i = 0; i < 4; ++i) {
#pragma unroll
            for (int s = 0; s < 2; ++s) {
                const float ar = akr[s][0], ai = aki[s][0];
                float xr[4], xi[4];
                xr[0] = D[s][4 * i]; xi[0] = D[2 + s][4 * i];
#pragma unroll
                for (int k = 1; k < 4; ++k) { xr[k] = ar * xr[k - 1] - ai * xi[k - 1] + D[s][4 * i + k]; xi[k] = ar * xi[k - 1] + ai * xr[k - 1] + D[2 + s][4 * i + k]; }
                const float pxr = swap32(xr[3], hh), pxi = swap32(xi[3], hh);
                const float cer = hh ? (akr[s][3] * cr[s] - aki[s][3] * ci[s] + pxr) : cr[s];
                const float cei = hh ? (akr[s][3] * ci[s] + aki[s][3] * cr[s] + pxi) : ci[s];
#pragma unroll
                for (int k = 0; k < 4; ++k) { const float hr = xr[k] + akr[s][k] * cer - aki[s][k] * cei, hi = xi[k] + akr[s][k] * cei + aki[s][k] * cer; D[s][4 * i + k] = hr; D[2 + s][4 * i + k] = hi; }
                const float phr = swap32(D[s][4 * i + 3], hh), phi = swap32(D[2 + s][4 * i + 3], hh);
                cr[s] = hh ? D[s][4 * i + 3] : phr; ci[s] = hh ? D[2 + s][4 * i + 3] : phi;
            }
        }
#pragma unroll
        for (int r = 0; r < 16; ++r) { const int t = (r & 3) + 8 * (r >> 2) + 4 * hh;
            *(LAS u32x2*)(hl + t * 272 + 8 * r32) = (u32x2){pkbf(D[0][r], D[1][r]), pkbf(D[2][r], D[3][r])}; }
        f32x4_ y[2];
#pragma unroll
        for (int mt = 0; mt < 2; ++mt) { y[mt] = (f32x4_){0.f, 0.f, 0.f, 0.f};
#pragma unroll
            for (int ks = 0; ks < 4; ++ks) y[mt] = MFMA16(Cm[ks], *(const LAS bf16x8*)(hl + (16 * mt + (lane & 15)) * 272 + (32 * ks + 8 * (lane >> 4)) * 2), y[mt]); }
#pragma unroll
        for (int mt = 0; mt < 2; ++mt) *(u32x2*)(dst + (size_t)scan_row(b, dir, 32 * tile + 16 * mt + (lane & 15)) * DM) = (u32x2){pkbf(y[mt][0], y[mt][1]), pkbf(y[mt][2], y[mt][3])};
        ua = un;
    }
}

__device__ __forceinline__ void lru_unit(const Params& P, int layer, int b, int dir, int head, int nh, LAS unsigned char* xl, int lane) {
    const int r32 = lane & 31, hh = lane >> 5;
    const int li = layer * 2 + dir;
    const bf16_t* PPu = WS_PTR(const bf16_t, OFF_P) + (size_t)(4 + (head >> 1)) * NTOK * PBLK + (head & 1) * 64;
    bf16_t* dstu = (dir ? WS_PTR(bf16_t, OFF_PB) : WS_PTR(bf16_t, OFF_HB)) + 512 + head * 64 + 32 * nh;
    const int sto = r32 + ((dir ? !hh : hh) ? 4 * DM : 0);
    float cw[4];
#pragma unroll
    for (int k = 0; k < 4; ++k) cw[k] = P.lru_conv_w[(layer * 4 + k) * 512 + head * 64 + lane];
    const float cb = P.lru_conv_b[layer * 512 + head * 64 + lane];
    bf16x8 Ba[4], Bx[4];
#pragma unroll
    for (int ks = 0; ks < 4; ++ks) { float va[8], vx[8];
#pragma unroll
        for (int jj = 0; jj < 8; ++jj) { const int i = 16 * ks + 8 * hh + jj; const size_t o = (((size_t)li * 8 + head) * 64 + i) * 64 + 32 * nh + r32; va[jj] = P.lru_wa[o]; vx[jj] = P.lru_wx[o]; }
        Ba[ks] = pack8(va[0], va[1], va[2], va[3], va[4], va[5], va[6], va[7]); Bx[ks] = pack8(vx[0], vx[1], vx[2], vx[3], vx[4], vx[5], vx[6], vx[7]); }
    const int chj = head * 64 + 32 * nh + r32;
    const float ba = P.lru_ba[li * 512 + chj], bx = P.lru_bx[li * 512 + chj];
    const float spl8 = -8.0f * log1pf(expf(-P.lru_lam[li * 512 + chj]));
    float cin = 0.f;
    unsigned short rawA[35], rawB[35];
    auto load_raw = [&](int tile, unsigned short (&r16)[35]) {
        int base, len, tt;
        if (tile < CTXL / 32) { base = NLAT + b * CTXL; len = CTXL; tt = tile; } else { base = b * SEQ; len = SEQ; tt = tile - CTXL / 32; }
        const int nmin = dir ? len - 32 - 32 * tt : 32 * tt;
        if (nmin >= 2 && nmin + 33 <= len) {
            const bf16_t* p = PPu + (size_t)(base + nmin - 2) * PBLK + lane;
#pragma unroll
            for (int wq = 0; wq < 35; ++wq) { r16[wq] = *p; p += PBLK; asm volatile("" : "+v"(p)); }
        } else {
#pragma unroll
            for (int wq = 0; wq < 35; ++wq) { int np = nmin - 2 + wq; np = np < 0 ? 0 : (np >= len ? len - 1 : np); r16[wq] = (PPu + (size_t)(base + np) * PBLK)[lane]; }
        }
    };
    auto do_tile = [&](int tile, unsigned short (&r16)[35]) {
        int base, len, tt;
        if (tile < CTXL / 32) { base = NLAT + b * CTXL; len = CTXL; tt = tile; } else { base = b * SEQ; len = SEQ; tt = tile - CTXL / 32; }
        const int nmin = dir ? len - 32 - 32 * tt : 32 * tt;
        float raw[35];
        if (nmin >= 2 && nmin + 33 <= len) {
#pragma unroll
            for (int wq = 0; wq < 35; ++wq) raw[wq] = bf2f(r16[wq]);
        } else {
#pragma unroll
            for (int wq = 0; wq < 35; ++wq) { const int np = nmin - 2 + wq; raw[wq] = (np >= 0 && np < len) ? bf2f(r16[wq]) : 0.f; }
        }
#pragma unroll
        for (int m = 0; m < 32; ++m) { const float xc = cb + cw[0] * raw[m] + cw[1] * raw[m + 1] + cw[2] * raw[m + 2] + cw[3] * raw[m + 3];
            const int q = dir ? 31 - m : m; *(LAS bf16_t*)(xl + q * 144 + lane * 2) = (bf16_t)pkbf(xc, xc); }
        if (tile + 2 < SCAN / 32) load_raw(tile + 2, r16);
        f32x16 accA, accX;
#pragma unroll
        for (int i = 0; i < 16; ++i) { accA[i] = 0.f; accX[i] = 0.f; }
#pragma unroll
        for (int ks = 0; ks < 4; ++ks) { const bf16x8 af = *(const LAS bf16x8*)(xl + r32 * 144 + (16 * ks + 8 * hh) * 2); accA = MFMA32(af, Ba[ks], accA); accX = MFMA32(af, Bx[ks], accX); }
#pragma unroll
        for (int i = 0; i < 4; ++i) {
            float x[4], A[4];
#pragma unroll
            for (int k = 0; k < 4; ++k) { const int r = 4 * i + k, q = k + 8 * i + 4 * hh;
                const float xc = bf2f(*(const LAS bf16_t*)(xl + q * 144 + (32 * nh + r32) * 2));
                const float rg = sigmoidf_(accA[r] + ba), ig = sigmoidf_(accX[r] + bx);
                const float a = __expf(spl8 * rg);
                const float bb = __builtin_amdgcn_sqrtf(fmaxf(1.0f - a * a, 0.f)) * (ig * xc);
                if (k == 0) { x[0] = bb; A[0] = a; } else { x[k] = a * x[k - 1] + bb; A[k] = a * A[k - 1]; } }
            const float px3 = swap32(x[3], hh), pA3 = swap32(A[3], hh);
            const float ce = hh ? (pA3 * cin + px3) : cin;
            float h[4];
#pragma unroll
            for (int k = 0; k < 4; ++k) h[k] = x[k] + A[k] * ce;
            const float ph3 = swap32(h[3], hh);
            cin = hh ? h[3] : ph3;
#pragma unroll
            for (int k = 0; k < 4; ++k) { const int q0 = k + 8 * i, npu = dir ? nmin + 31 - q0 - 4 : nmin + q0; (dstu + (size_t)(base + npu) * DM)[sto] = (bf16_t)pkbf(h[k], h[k]); }
        }
    };
    load_raw(0, rawA); load_raw(1, rawB);
    for (int tile = 0; tile < SCAN / 32; tile += 2) { do_tile(tile, rawA); do_tile(tile + 1, rawB); }
}

constexpr int MIX_CQ = 4 * S5_LDS + 2 * LRU_LDS + 4 * 8448;
__device__ __forceinline__ void phase_s5_lru(const Params& P, int layer, LAS unsigned char* lds, int bid, int nblk, int wv) {
    const int tid = tid_(wv), lane = tid & 63, w = __builtin_amdgcn_readfirstlane(tid >> 6);
    LAS int* cq = (LAS int*)(lds + MIX_CQ);
    __syncthreads();
    if (tid == 0) *cq = 0;
    __syncthreads();
    LAS float* scr;
    if (w < 2) {
        for (int j = bid; j < NB * 2 * 8; j += nblk) lru_unit(P, layer, j >> 4, j & 1, (j >> 1) & 7, w, lds + 4 * S5_LDS + w * LRU_LDS, lane);
        scr = (LAS float*)(lds + 4 * S5_LDS + 2 * LRU_LDS + (2 + w) * 8448);
    } else if (w == 4 || w == 5) {
        scr = (LAS float*)(lds + 4 * S5_LDS + 2 * LRU_LDS + (w - 4) * 8448);
    } else {
        const int sw = (w & 1) + ((w >> 2) << 1);
        for (int j = bid; j < NB * 8 * 2; j += nblk) s5_unit(P, layer, j >> 4, 4 * ((j >> 1) & 7) + sw, j & 1, lds + sw * S5_LDS, lane);
        scr = (LAS float*)(lds + sw * S5_LDS);
    }
    convert_moe_queue(P, layer, scr, cq, bid, nblk, lane);
    __syncthreads();
}
__device__ __forceinline__ void phase_gemm_in(const Params& P, int layer, LAS unsigned char* lds, int bid, int nblk, int wv) {
    pg8::Gemm g{WS_PTR(const bf16_t, OFF_HB), WS_PTR(const bf16_t, OFF_WIN) + (size_t)layer * NPC * DM, NTOK, NPC, DM};
    pg8::EpiPlainBf16 E{WS_PTR(bf16_t, OFF_P), 0  , 6 * 512 / 256, 7 * 512 / 256};
    if (layer == 0) { pg8::StaticOrder S; S.init(NTOK, NPC, nblk, bid); pg8::gemm_phase<pg8::EpiPlainBf16, pg8::StaticOrder, true, true>(lds, g, S, E, wv); }
    else { pg8::InOrderLast S; S.init(nblk, bid); pg8::gemm_phase<pg8::EpiPlainBf16, pg8::InOrderLast, true, true>(lds, g, S, E, wv); }
}
__device__ __forceinline__ void phase_gemm_glu(const Params& P, int layer, int nrows, LAS unsigned char* lds, int bid, int nblk, int wv) {
    pg8::Gemm g{WS_PTR(const bf16_t, OFF_GY), WS_PTR(const bf16_t, OFF_WGLU) + (size_t)layer * 512 * 512, nrows, 512, 512};
    pg8::StaticOrder S; S.init(nrows, 512, nblk, bid);
    pg8::EpiGlu E{WS_PTR(bf16_t, OFF_HB), DM, WS_PTR(const bf16_t, OFF_GY), P.s5_glu_b + layer * 512};
    pg8::gemm_phase<pg8::EpiGlu, pg8::StaticOrder, true, true>(lds, g, S, E, wv);
}
__device__ __forceinline__ void phase_gemm_out(const Params& P, int layer, int nrows, LAS unsigned char* lds, int bid, int nblk, int wv) {
    pg8::Gemm g{WS_PTR(const bf16_t, OFF_HB), WS_PTR(const bf16_t, OFF_WOUT) + (size_t)layer * DM * DM, nrows, DM, DM};
    pg8::StaticOrder S; S.init(nrows, DM, nblk, bid);
    pg8::EpiResid E{WS_PTR(bf16_t, OFF_X), WS_PTR(const float, OFF_MOD) + (size_t)layer * 17 * 12288 + 2 * 2048, layer == 0 ? P.x : nullptr, layer == 0 ? P.ctx : nullptr};
    pg8::gemm_phase<pg8::EpiResid, pg8::StaticOrder, true, true>(lds, g, S, E, wv);
}
__device__ __forceinline__ void phase_gemm_moe1(const Params& P, LAS unsigned char* lds, int bid, int nblk, int wv) {
    pg8::Gemm g{WS_PTR(const bf16_t, OFF_HB), WS_PTR(const bf16_t, OFF_W1), MPAD, 2048, DM};
    pg8::MoeOrder S{WS_PTR(const int, OFF_TILE), WS_PTR(const int, OFF_TILE)[511], nblk, bid};
    LAS unsigned* gtab = (LAS unsigned*)(lds + 131072);
    { const int tid = tid_(wv); const int* ST = WS_PTR(const int, OFF_SORTTOK);
      __syncthreads();
      for (int i = 0; i < 12; ++i) { pg8::Unit u; if (!S.next(i, u)) break;
          if (tid < 256) { const int tok = ST[u.pm * 256 + tid]; gtab[i * 256 + tid] = (unsigned)(tok < 0 ? 0 : tok) * (unsigned)(DM * 2); } }
      __syncthreads(); }
    pg8::EpiSwiGlu E{WS_PTR(bf16_t, OFF_HE)};
    pg8::gemm_phase<pg8::EpiSwiGlu, pg8::MoeOrder, true, true, true>(lds, g, S, E, wv, gtab);
}
__device__ __forceinline__ void phase_gemm_moe2(const Params& P, LAS unsigned char* lds, int bid, int nblk, int wv) {
    pg8::Gemm g{WS_PTR(const bf16_t, OFF_HE), WS_PTR(const bf16_t, OFF_W2), MPAD, 2048, DFF};
    pg8::MoeOrder S{WS_PTR(const int, OFF_TILE), WS_PTR(const int, OFF_TILE)[511], nblk, bid};
    pg8::EpiScaleRow E{WS_PTR(bf16_t, OFF_YBUF), WS_PTR(const float, OFF_SORTGATE)};
    pg8::gemm_phase<pg8::EpiScaleRow, pg8::MoeOrder, true, true>(lds, g, S, E, wv);
}

constexpr int LDS_BYTES = 147456;
constexpr int LDS_BARW = LDS_BYTES - 64;
__device__ __forceinline__ Params load_params() {
    typedef const unsigned long long __attribute__((address_space(4)))* KA;
    typedef const float __attribute__((address_space(1)))* GCF;
    KA ka = (KA)__builtin_amdgcn_kernarg_segment_ptr();
    asm volatile("" : "+s"(ka));
    Params P; const float** d = (const float**)&P;
#pragma unroll
    for (int i = 0; i < 34; ++i) d[i] = (const float*)(GCF)ka[i];
    P.out = (float*)(float __attribute__((address_space(1)))*)ka[34];
    P.ws = (unsigned char*)(unsigned char __attribute__((address_space(1)))*)ka[35];
    return P;
}
#define PH(call) do { const Params P = load_params(); call; } while (0)
__global__ void __launch_bounds__(512, 2) k_forward(Params P_arg_unused) {
    extern __shared__ __attribute__((aligned(16))) unsigned char lds_raw[];
    LAS unsigned char* lds = (LAS unsigned char*)lds_raw;
    const int bid = blockIdx.x, nblk = gridDim.x;
    const int wv = __builtin_amdgcn_readfirstlane(threadIdx.x >> 6);
    if (threadIdx.x < 16) ((LAS unsigned*)(lds + LDS_BARW))[threadIdx.x] = 0u;
    __syncthreads();
    (void)xcd_barrier_post((unsigned*)(load_params().ws + OFF_CTL), (volatile LAS unsigned*)(lds + LDS_BARW));
#define GRID_BAR() do { XcdBarrier b_; b_.bar = (unsigned*)(load_params().ws + OFF_CTL); b_.x = xb_xcc_id(); b_.st = (volatile LAS unsigned*)(lds + LDS_BARW); xcd_barrier(b_); } while (0)
    PH(phase_mod(P, 0, 2, lds, bid, nblk, wv));
    { const int skip = nblk > 96 ? 96 : 0;
      if (bid >= skip) PH(phase_convert_small(P, 0, 2, lds, bid - skip, nblk - skip, wv)); }
    GRID_BAR();
    for (int layer = 0; layer < 2; ++layer) {
        const int nrows = layer == 0 ? NTOK : NLAT;
        PH(phase_norm1(P, layer, bid, nblk, wv));
        GRID_BAR();
        PH(phase_gemm_in(P, layer, lds, bid, nblk, wv));
        GRID_BAR();
        PH(phase_s5_lru(P, layer, lds, bid, nblk, wv));
        PH(phase_gla_chunk(P, layer, lds, bid, nblk, wv));
        GRID_BAR();
        PH(phase_finalize_s5(P, layer, nrows, bid, nblk, wv));
        GRID_BAR();
        { const int NGLU = nblk >= 192 ? 96 : 0;
          if (NGLU == 0) { PH(phase_finalize_rest(P, layer, nrows, bid, nblk, wv)); GRID_BAR(); PH(phase_gemm_glu(P, layer, nrows, lds, bid, nblk, wv)); }
          else if (bid < NGLU) PH(phase_gemm_glu(P, layer, nrows, lds, bid, NGLU, wv));
          else PH(phase_finalize_rest(P, layer, nrows, bid - NGLU, nblk - NGLU, wv)); }
        GRID_BAR();
        PH(phase_gemm_out(P, layer, nrows, lds, bid, nblk, wv));
        GRID_BAR();
        PH(phase_norm2(P, layer, 256, nrows / 256, lds, bid, nblk, wv));
        GRID_BAR();
        PH(phase_route2(P, 256, nrows / 256, lds, bid, nblk, wv));
        GRID_BAR();
        PH(phase_gemm_moe1(P, lds, bid, nblk, wv));
        GRID_BAR();
        PH(phase_gemm_moe2(P, lds, bid, nblk, wv));
        GRID_BAR();
    }
    PH(phase_final(P, bid, nblk, wv));
}

extern "C" void kernel_launch(void* const* d_in, const int* in_sizes, int n_in, void* d_out, int out_size, void* d_ws, size_t ws_size, hipStream_t stream) {
    static int grid = 0;
    if (grid == 0) {
        if (n_in != 34 || ws_size < WS_END) { fprintf(stderr, "kernel_launch: n_in %d ws %zu (need %zu)\n", n_in, ws_size, (size_t)WS_END); grid = -1; return; }
        int dev = 0, cus = 0, per_cu = 0;
        if (hipGetDevice(&dev) != hipSuccess || hipDeviceGetAttribute(&cus, hipDeviceAttributeMultiprocessorCount, dev) != hipSuccess) { grid = -1; return; }
        if (hipFuncSetAttribute((const void*)k_forward, hipFuncAttributeMaxDynamicSharedMemorySize, LDS_BYTES) != hipSuccess) { fprintf(stderr, "kernel_launch: hipFuncSetAttribute failed\n"); grid = -1; return; }
        if (hipOccupancyMaxActiveBlocksPerMultiprocessor(&per_cu, (const void*)k_forward, 512, LDS_BYTES) != hipSuccess || per_cu < 1) { fprintf(stderr, "kernel_launch: occupancy query says %d\n", per_cu); (void)hipGetLastError(); per_cu = 1; }
        grid = cus;
    }
    if (grid < 0) return;
    if (hipMemsetAsync((char*)d_ws + OFF_CTL, 0, CTL_BYTES, stream) != hipSuccess) return;
    Params P{};
    const float** pp = (const float**)&P;
    for (int i = 0; i < 34; ++i) pp[i] = (const float*)d_in[i];
    P.out = (float*)d_out; P.ws = (unsigned char*)d_ws;
    hipLaunchKernelGGL(k_forward, dim3(grid), dim3(512), LDS_BYTES, stream, P);
}
```
